# Optimizing an MI355X kernel written in HIP

```python
import math
import jax
import jax.numpy as jnp
from jax import lax
import numpy as np

D_MODEL = 1024
BATCH = 8
SEQ = 2048
DEPTH = 2
DEC_BATCH = 128
DEC_SEQ = 1
PAST_LEN = 16384
PAGE_SIZE = 128

N_AB = (DEPTH + 1) // 2
N_RET = DEPTH // 2
GDN_HEADS = 8
GDN_DK = 128
GDN_DV = 128
SSM_HEADS = 16
SSM_P = 64
SSM_N = 128
SSM_G = 2
CONV_W = 4
RET_HEADS = 4
RET_DK = 256
RET_DV = 512
ROPE_BASE = 10000.0
PEER_HEADS = 8
PEER_NKEYS = 128
PEER_EXPERTS = PEER_NKEYS * PEER_NKEYS
PEER_TOPK = 16
PEER_DQ = 256
PEER_BLOCK = 256
CHUNK = 64
EPS = 1e-6

GDN_QK = GDN_HEADS * GDN_DK
GDN_V = GDN_HEADS * GDN_DV
SSM_INNER = SSM_HEADS * SSM_P
SSM_BC = SSM_G * SSM_N
CONV_CH = 2 * GDN_QK + GDN_V + SSM_INNER + 2 * SSM_BC
AB_SPLIT = [CONV_CH, GDN_V, SSM_INNER, GDN_HEADS, GDN_HEADS, SSM_HEADS]
AB_IN = sum(AB_SPLIT)
CONV_SPLIT = [GDN_QK, GDN_QK, GDN_V, SSM_INNER, SSM_BC, SSM_BC]
AB_OUT = GDN_V + SSM_INNER
RET_QK = RET_HEADS * RET_DK
RET_V = RET_HEADS * RET_DV
RET_SPLIT = [RET_QK, RET_QK, RET_V, RET_V]
RET_IN = sum(RET_SPLIT)

kernel_name = 'hybrid_gdn_ssd_retention_peer_step'


def _cuts(sizes):
    return np.cumsum(sizes)[:-1].tolist()


def rmsnorm(x, g):
    xf = x.astype(jnp.float32)
    y = xf * lax.rsqrt(jnp.mean(xf * xf, axis=-1, keepdims=True) + EPS)
    return (y * g.astype(jnp.float32)).astype(x.dtype)


def l2norm(x):
    return x * lax.rsqrt(jnp.sum(x * x, axis=-1, keepdims=True) + EPS)


def causal_conv_silu(u, buf, w, b):
    L = u.shape[1]
    up = jnp.concatenate([buf.astype(u.dtype), u], axis=1)
    y = b + sum(up[:, i:i + L] * w[i] for i in range(CONV_W))
    return jax.nn.silu(y), up[:, L:]


def rope(x, pos0):
    L, d = x.shape[1], x.shape[-1]
    inv = ROPE_BASE ** (-jnp.arange(0, d, 2, dtype=jnp.float32) / d)
    ang = (pos0 + jnp.arange(L, dtype=jnp.float32))[:, None] * inv[None, :]
    cos, sin = jnp.cos(ang)[None, :, None, :], jnp.sin(ang)[None, :, None, :]
    x1, x2 = x[..., :d // 2], x[..., d // 2:]
    return jnp.concatenate([x1 * cos - x2 * sin, x1 * sin + x2 * cos], axis=-1)


def _chunking(L):
    c = min(CHUNK, L)
    n = -(-L // c)
    return c, n, n * c - L


def _to_chunks(a, c, n, pad):
    a = jnp.pad(a, [(0, 0), (0, pad)] + [(0, 0)] * (a.ndim - 2))
    a = a.reshape(a.shape[0], n, c, *a.shape[2:])
    return jnp.moveaxis(a, 1, 0)


def _from_chunks(a, L):
    a = jnp.moveaxis(a, 0, 1)
    a = a.reshape(a.shape[0], -1, *a.shape[3:])
    return a[:, :L]


def decay_linear_attn(q, k, v, log_a, s0):
    f32 = jnp.float32
    L = q.shape[1]
    c, n, pad = _chunking(L)
    qc, kc, vc, gc = (_to_chunks(t.astype(f32), c, n, pad) for t in (q, k, v, log_a))
    mask = jnp.tril(jnp.ones((c, c), dtype=bool))

    def step(s, inp):
        qi, ki, vi, gi = inp
        cum = jnp.cumsum(gi, axis=1)
        diff = cum[:, :, None, :] - cum[:, None, :, :]
        dec = jnp.exp(jnp.where(mask[None, :, :, None], diff, -jnp.inf))
        scores = jnp.einsum('bihd,bjhd->bijh', qi, ki) * dec
        o = (jnp.einsum('bijh,bjhe->bihe', scores, vi)
             + jnp.einsum('bihd,bhde->bihe', qi * jnp.exp(cum)[..., None], s))
        last = cum[:, -1]
        kd = ki * jnp.exp(last[:, None, :] - cum)[..., None]
        s = s * jnp.exp(last)[:, :, None, None] + jnp.einsum('bjhd,bjhe->bhde', kd, vi)
        return s, o

    s, o = lax.scan(step, s0.astype(f32), (qc, kc, vc, gc))
    return _from_chunks(o, L), s


def gated_delta_rule(q, k, v, beta, g, s0):
    f32 = jnp.float32
    L, dv = q.shape[1], v.shape[-1]
    c, n, pad = _chunking(L)
    heads_first = lambda t: jnp.moveaxis(_to_chunks(t.astype(f32), c, n, pad), 3, 2)
    qh, kh, vh, bh, gh = (heads_first(t) for t in (q, k, v, beta, g))
    gh = jnp.cumsum(gh, axis=-1)
    incl = jnp.tril(jnp.ones((c, c), dtype=bool))
    strict = jnp.tril(jnp.ones((c, c), dtype=bool), -1)
    diff = gh[..., :, None] - gh[..., None, :]
    dec_strict = jnp.exp(jnp.where(strict, diff, -jnp.inf))
    dec_incl = jnp.exp(jnp.where(incl, diff, -jnp.inf))
    lower = (bh[..., :, None] * jnp.einsum('nbhid,nbhjd->nbhij', kh, kh) * dec_strict
             + jnp.eye(c, dtype=f32))
    rhs = jnp.concatenate([vh * bh[..., None], kh * (bh * jnp.exp(gh))[..., None]], axis=-1)
    sol = lax.linalg.triangular_solve(lower, rhs, left_side=True, lower=True, unit_diagonal=True)
    u0, w = sol[..., :dv], sol[..., dv:]
    qk = jnp.einsum('nbhid,nbhjd->nbhij', qh, kh) * dec_incl

    def step(s, inp):
        qi, ki, u0i, wi, qki, gi = inp
        u = u0i - jnp.einsum('bhid,bhde->bhie', wi, s)
        o = (jnp.einsum('bhid,bhde->bhie', qi * jnp.exp(gi)[..., None], s)
             + jnp.einsum('bhij,bhje->bhie', qki, u))
        last = gi[..., -1]
        kd = ki * jnp.exp(last[..., None] - gi)[..., None]
        s = s * jnp.exp(last)[..., None, None] + jnp.einsum('bhjd,bhje->bhde', kd, u)
        return s, o

    s, o = lax.scan(step, s0.astype(f32), (qh, kh, u0, w, qk, gh))
    return _from_chunks(jnp.moveaxis(o, 2, 3), L), s


def mixer_ab(h, conv_buf, gdn_s, ssm_s, w_in, conv_w, conv_b, gdn_a_log, gdn_dt_bias, gdn_norm_g,
             ssm_a_log, ssm_dt_bias, ssm_d, ssm_norm_g, w_out):
    f32 = jnp.float32
    B_, L, _ = h.shape
    proj = (h @ w_in).astype(f32)
    xbc, gate, z, b_raw, a_raw, dt_raw = jnp.split(proj, _cuts(AB_SPLIT), axis=-1)
    xbc, conv_new = causal_conv_silu(xbc, conv_buf, conv_w.astype(f32), conv_b.astype(f32))
    q, k, v, xs, bm, cm = jnp.split(xbc, _cuts(CONV_SPLIT), axis=-1)
    q = l2norm(q.reshape(B_, L, GDN_HEADS, GDN_DK)) * GDN_DK ** -0.5
    k = l2norm(k.reshape(B_, L, GDN_HEADS, GDN_DK))
    v = v.reshape(B_, L, GDN_HEADS, GDN_DV)
    beta = jax.nn.sigmoid(b_raw)
    g = -jnp.exp(gdn_a_log.astype(f32)) * jax.nn.softplus(a_raw + gdn_dt_bias.astype(f32))
    o_a, gdn_new = gated_delta_rule(q, k, v, beta, g, gdn_s)
    o_a = rmsnorm(o_a, gdn_norm_g) * jax.nn.silu(gate.reshape(B_, L, GDN_HEADS, GDN_DV))
    dt = jax.nn.softplus(dt_raw + ssm_dt_bias.astype(f32))
    xs = xs.reshape(B_, L, SSM_HEADS, SSM_P)
    rep = SSM_HEADS // SSM_G
    bm = jnp.repeat(bm.reshape(B_, L, SSM_G, SSM_N), rep, axis=2)
    cm = jnp.repeat(cm.reshape(B_, L, SSM_G, SSM_N), rep, axis=2)
    log_a = -dt * jnp.exp(ssm_a_log.astype(f32))
    o_b, ssm_new = decay_linear_attn(cm, bm * dt[..., None], xs, log_a, ssm_s)
    o_b = (o_b + ssm_d.astype(f32)[:, None] * xs).reshape(B_, L, SSM_INNER)
    o_b = rmsnorm(o_b * jax.nn.silu(z), ssm_norm_g)
    out = jnp.concatenate([o_a.reshape(B_, L, GDN_V), o_b], axis=-1) @ w_out
    return out.astype(h.dtype), conv_new, gdn_new, ssm_new


def mixer_ret(h, ret_s, pos0, w_in, norm_g, w_out):
    f32 = jnp.float32
    B_, L, _ = h.shape
    proj = (h @ w_in).astype(f32)
    q, k, v, gate = jnp.split(proj, _cuts(RET_SPLIT), axis=-1)
    q = rope(q.reshape(B_, L, RET_HEADS, RET_DK), pos0)
    k = rope(k.reshape(B_, L, RET_HEADS, RET_DK), pos0) * RET_DK ** -0.5
    v = v.reshape(B_, L, RET_HEADS, RET_DV)
    log_gamma = jnp.log(1.0 - 2.0 ** (-5.0 - jnp.arange(RET_HEADS, dtype=f32)))
    log_a = jnp.broadcast_to(log_gamma, (B_, L, RET_HEADS))
    o, s = decay_linear_attn(q, k, v, log_a, ret_s)
    mu = jnp.mean(o, axis=-1, keepdims=True)
    var = jnp.mean(jnp.square(o - mu), axis=-1, keepdims=True)
    o = (o - mu) * lax.rsqrt(var + EPS) * norm_g.astype(f32)
    o = jax.nn.silu(gate) * o.reshape(B_, L, RET_V)
    return (o @ w_out).astype(h.dtype), s


def peer(h, w_q, keys, u, v):
    B_, L, D = h.shape
    T = B_ * L
    blk = min(PEER_BLOCK, T)
    nblk = -(-T // blk)
    xt = jnp.pad(h.reshape(T, D), ((0, nblk * blk - T), (0, 0))).reshape(nblk, blk, D)

    def block(xb):
        q = (xb @ w_q).astype(jnp.float32).reshape(blk, PEER_HEADS, 2, PEER_DQ // 2)
        s = jnp.einsum('thpd,pnd->thpn', q, keys.astype(jnp.float32))
        sv, si = lax.top_k(s, PEER_TOPK)
        cand = (sv[:, :, 0, :, None] + sv[:, :, 1, None, :]).reshape(blk, PEER_HEADS, PEER_TOPK * PEER_TOPK)
        cv, ci = lax.top_k(cand, PEER_TOPK)
        idx = (jnp.take_along_axis(si[:, :, 0], ci // PEER_TOPK, axis=-1) * PEER_NKEYS
               + jnp.take_along_axis(si[:, :, 1], ci % PEER_TOPK, axis=-1))
        gate = jax.nn.softmax(cv, axis=-1)
        act = jax.nn.gelu(jnp.einsum('td,thkd->thk', xb, u[idx]).astype(jnp.float32), approximate=False) * gate
        return jnp.einsum('thk,thkd->td', act.astype(xb.dtype), v[idx])

    y = lax.map(block, xt)
    return y.reshape(nblk * blk, D)[:T].reshape(B_, L, D)


def trunk(x, c, pos0, conv0, gdn0, ssm0, ret0, weights):
    (ada_w, ada_b, norm1_g, norm2_g, ab_w_in, ab_conv_w, ab_conv_b, gdn_a_log, gdn_dt_bias,
     gdn_norm_g, ssm_a_log, ssm_dt_bias, ssm_d, ssm_norm_g, ab_w_out, ret_w_in, ret_norm_g,
     ret_w_out, peer_w_q, peer_keys, peer_u, peer_v, final_g) = weights
    convs, gdns, ssms, rets = [], [], [], []
    for layer in range(DEPTH):
        mod = jax.nn.silu(c) @ ada_w[layer] + ada_b[layer]
        sh1, sc1, g1, sh2, sc2, g2 = jnp.split(mod[:, None, :], 6, axis=-1)
        hm = rmsnorm(x, norm1_g[layer]) * (1 + sc1) + sh1
        i = layer // 2
        if layer % 2 == 0:
            out, cs, gs, ss = mixer_ab(hm, conv0[i], gdn0[i], ssm0[i], ab_w_in[i], ab_conv_w[i],
                                       ab_conv_b[i], gdn_a_log[i], gdn_dt_bias[i], gdn_norm_g[i],
                                       ssm_a_log[i], ssm_dt_bias[i], ssm_d[i], ssm_norm_g[i],
                                       ab_w_out[i])
            convs.append(cs)
            gdns.append(gs)
            ssms.append(ss)
        else:
            out, rs = mixer_ret(hm, ret0[i], pos0, ret_w_in[i], ret_norm_g[i], ret_w_out[i])
            rets.append(rs)
        x = x + g1 * out
        hm = rmsnorm(x, norm2_g[layer]) * (1 + sc2) + sh2
        x = x + g2 * peer(hm, peer_w_q[layer], peer_keys[layer], peer_u[layer], peer_v[layer])
    return rmsnorm(x, final_g), jnp.stack(convs), jnp.stack(gdns), jnp.stack(ssms), jnp.stack(rets)


def setup_inputs(seed: int = 0) -> dict:
    key = jax.random.key(seed)
    ks = iter(jax.random.split(key, 40))
    f32 = jnp.float32

    def nrm(shape, scale):
        return jax.random.normal(next(ks), shape, f32) * scale

    def dt_bias(shape):
        dt = jnp.exp(jax.random.uniform(next(ks), shape, f32, math.log(1e-3), math.log(1e-1)))
        return dt + jnp.log(-jnp.expm1(-dt))

    def a_log(shape):
        return jnp.log(jax.random.uniform(next(ks), shape, f32, 1.0, 16.0))

    return {
        'x_prompt': nrm((BATCH, SEQ, D_MODEL), 1.0),
        'x_sample': nrm((DEC_BATCH, DEC_SEQ, D_MODEL), 1.0),
        'c_prompt': nrm((BATCH, D_MODEL), 1.0),
        'c_sample': nrm((DEC_BATCH, D_MODEL), 1.0),
        'state_conv': nrm((N_AB, DEC_BATCH, CONV_W - 1, CONV_CH), 1.0),
        'state_gdn': nrm((N_AB, DEC_BATCH, GDN_HEADS, GDN_DK, GDN_DV), 0.1),
        'state_ssm': nrm((N_AB, DEC_BATCH, SSM_HEADS, SSM_N, SSM_P), 0.1),
        'state_ret': nrm((N_RET, DEC_BATCH, RET_HEADS, RET_DK, RET_DV), 0.1),
        'ada_w': nrm((DEPTH, D_MODEL, 6 * D_MODEL), 0.5 * D_MODEL ** -0.5),
        'ada_b': nrm((DEPTH, 6 * D_MODEL), 0.02),
        'norm1_g': 1.0 + nrm((DEPTH, D_MODEL), 0.02),
        'norm2_g': 1.0 + nrm((DEPTH, D_MODEL), 0.02),
        'ab_w_in': nrm((N_AB, D_MODEL, AB_IN), D_MODEL ** -0.5),
        'ab_conv_w': nrm((N_AB, CONV_W, CONV_CH), CONV_W ** -0.5),
        'ab_conv_b': nrm((N_AB, CONV_CH), 0.02),
        'gdn_a_log': a_log((N_AB, GDN_HEADS)),
        'gdn_dt_bias': dt_bias((N_AB, GDN_HEADS)),
        'gdn_norm_g': 1.0 + nrm((N_AB, GDN_DV), 0.02),
        'ssm_a_log': a_log((N_AB, SSM_HEADS)),
        'ssm_dt_bias': dt_bias((N_AB, SSM_HEADS)),
        'ssm_d': 1.0 + nrm((N_AB, SSM_HEADS), 0.1),
        'ssm_norm_g': 1.0 + nrm((N_AB, SSM_INNER), 0.02),
        'ab_w_out': nrm((N_AB, AB_OUT, D_MODEL), AB_OUT ** -0.5),
        'ret_w_in': nrm((N_RET, D_MODEL, RET_IN), D_MODEL ** -0.5),
        'ret_norm_g': 1.0 + nrm((N_RET, RET_HEADS, RET_DV), 0.02),
        'ret_w_out': nrm((N_RET, RET_V, D_MODEL), RET_V ** -0.5),
        'peer_w_q': nrm((DEPTH, D_MODEL, PEER_HEADS * PEER_DQ), D_MODEL ** -0.5),
        'peer_keys': nrm((DEPTH, 2, PEER_NKEYS, PEER_DQ // 2), (PEER_DQ // 2) ** -0.5),
        'peer_u': nrm((DEPTH, PEER_EXPERTS, D_MODEL), D_MODEL ** -0.5),
        'peer_v': nrm((DEPTH, PEER_EXPERTS, D_MODEL), 0.3),
        'final_g': 1.0 + nrm((D_MODEL,), 0.02),
    }


def reference(x_prompt, x_sample, c_prompt, c_sample, state_conv, state_gdn, state_ssm, state_ret,
              ada_w, ada_b, norm1_g, norm2_g, ab_w_in, ab_conv_w, ab_conv_b, gdn_a_log, gdn_dt_bias,
              gdn_norm_g, ssm_a_log, ssm_dt_bias, ssm_d, ssm_norm_g, ab_w_out, ret_w_in, ret_norm_g,
              ret_w_out, peer_w_q, peer_keys, peer_u, peer_v, final_g):
    weights = (ada_w, ada_b, norm1_g, norm2_g, ab_w_in, ab_conv_w, ab_conv_b, gdn_a_log, gdn_dt_bias,
               gdn_norm_g, ssm_a_log, ssm_dt_bias, ssm_d, ssm_norm_g, ab_w_out, ret_w_in, ret_norm_g,
               ret_w_out, peer_w_q, peer_keys, peer_u, peer_v, final_g)
    nb = x_prompt.shape[0]
    zeros = lambda s: jnp.zeros((s.shape[0], nb) + s.shape[2:], s.dtype)
    y_prompt, p_conv, p_gdn, p_ssm, p_ret = trunk(
        x_prompt, c_prompt, 0, zeros(state_conv), zeros(state_gdn), zeros(state_ssm), zeros(state_ret), weights)
    y_sample, s_conv, s_gdn, s_ssm, s_ret = trunk(
        x_sample, c_sample, PAST_LEN, state_conv, state_gdn, state_ssm, state_ret, weights)
    return (y_prompt, y_sample, p_conv, p_gdn, p_ssm, p_ret, s_conv, s_gdn, s_ssm, s_ret)
```

```cpp
#include <hip/hip_runtime.h>
#include <hip/hip_cooperative_groups.h>
#include <cstdio>
#include <cstdint>
namespace cg = cooperative_groups;
#define STOP_AFTER 0
#define REP_GEMM 1
#define DBG_NCH 32
#ifndef REP_SCAN
#define REP_SCAN 1
#endif
#ifndef REP_PREP
#define REP_PREP 1
#endif
#ifndef REP_P0
#define REP_P0 1
#endif
#ifndef REP_SYNC
#define REP_SYNC 0
#endif
#ifndef REP_ELT
#define REP_ELT 1
#endif
#ifndef REP_GEMM
#define REP_GEMM 1
#endif
#ifndef REP_TOPK
#define REP_TOPK 1
#endif
#ifndef REP_GATHER
#define REP_GATHER 1
#endif

typedef unsigned short bf16_t;
typedef short bf16x8 __attribute__((ext_vector_type(8)));
typedef float f32x4 __attribute__((ext_vector_type(4)));
#define LDS_AS __attribute__((address_space(3)))

constexpr int D = 1024, NTOK = 16512, NPT = 16384, SEQ = 2048, NSEQ = 136;
constexpr int AB_IN = 6688, AB_IN_PAD = 6784, CONV_CH = 4608, GZ_W = 2080, RET_IN = 6144;
constexpr int NTHR = 256;
constexpr float U_SCALE = 256.f, V_SCALE = 16.f;
constexpr int LDS_BYTES = 77824;

constexpr size_t O_Y = 0, O_CONVP = 16908288, O_GDNP = 17018880, O_SSMP = 18067456, O_RETP = 19116032,
                 O_CONVS = 23310336, O_GDNS = 25079808, O_SSMS = 41857024, O_RETS = 58634240;

constexpr size_t al256(size_t x) { return (x + 255) & ~(size_t)255; }
constexpr size_t W_ADA_T = 0;
constexpr size_t W_IN0_T = W_ADA_T + al256((size_t)12288 * 1024 * 2);
constexpr size_t W_OUT0_T = W_IN0_T + al256((size_t)AB_IN_PAD * 1024 * 2);
constexpr size_t W_IN1_T = W_OUT0_T + al256((size_t)1024 * 2048 * 2);
constexpr size_t W_OUT1_T = W_IN1_T + al256((size_t)6144 * 1024 * 2);
constexpr size_t W_Q_T = W_OUT1_T + al256((size_t)1024 * 2048 * 2);
constexpr size_t W_KEYS = W_Q_T + al256((size_t)2 * 2048 * 1024 * 2);
constexpr size_t W_U = W_KEYS + al256((size_t)2 * 2 * 128 * 128 * 2);
constexpr size_t W_V = W_U + al256((size_t)2 * 16384 * 1024 * 2);
constexpr size_t W_SILUC = W_V + al256((size_t)2 * 16384 * 1024 * 2);
constexpr size_t W_MOD = W_SILUC + al256((size_t)256 * 1024 * 2);
constexpr size_t W_X = W_MOD + al256((size_t)NSEQ * 12288 * 4);
constexpr size_t W_HM = W_X + al256((size_t)NTOK * 1024 * 4);
constexpr size_t W_SCAL = W_HM + al256((size_t)NTOK * 1024 * 2);
constexpr size_t W_GZ = W_SCAL + al256((size_t)NTOK * 48 * 4);
constexpr size_t W_XBC = W_GZ + al256((size_t)NTOK * GZ_W * 2);
constexpr size_t W_ORAW = W_XBC + al256((size_t)NTOK * CONV_CH * 2);
constexpr size_t W_A2 = W_ORAW + al256((size_t)NTOK * 2048 * 2);
constexpr size_t W_TKI = W_A2 + al256((size_t)NTOK * 2048 * 2);
constexpr size_t W_TKG = W_TKI + al256((size_t)NTOK * 128 * 4);
constexpr size_t W_DEC = W_TKG + al256((size_t)NTOK * 128 * 4);
constexpr size_t W_BAR = W_DEC + al256((size_t)8192 * 4);
constexpr size_t W_BIG = W_BAR + al256((size_t)4096 * 4);
constexpr size_t GDN_BLOB = 73728, SSD_BLOB = 40960, RET_BLOB = 73728;
constexpr size_t W_PRE = W_BIG;
constexpr size_t W_GDNB = W_BIG;
constexpr size_t W_SSDB = W_GDNB + al256(2048 * GDN_BLOB);
constexpr size_t W_PROJ1 = W_BIG;
constexpr size_t W_RETB = W_PROJ1 + al256((size_t)NTOK * RET_IN * 2);
constexpr size_t W_END0 = W_SSDB + al256(4096 * SSD_BLOB);
constexpr size_t W_END1 = W_RETB + al256(1024 * RET_BLOB);
constexpr size_t W_END = W_END0 > W_END1 ? W_END0 : W_END1;

struct Params {
  const float *x_prompt, *x_sample, *c_prompt, *c_sample, *state_conv, *state_gdn, *state_ssm, *state_ret;
  const float *ada_w, *ada_b, *norm1_g, *norm2_g, *ab_w_in, *ab_conv_w, *ab_conv_b, *gdn_a_log, *gdn_dt_bias, *gdn_norm_g;
  const float *ssm_a_log, *ssm_dt_bias, *ssm_d, *ssm_norm_g, *ab_w_out, *ret_w_in, *ret_norm_g, *ret_w_out;
  const float *peer_w_q, *peer_keys, *peer_u, *peer_v, *final_g;
  float* out;
  char* ws;
};

__device__ __forceinline__ int tidx() { int t = threadIdx.x; asm volatile("" : "+v"(t)); return t; }
typedef __bf16 bf16x2_t __attribute__((ext_vector_type(2)));
typedef float f32x2_t __attribute__((ext_vector_type(2)));
__device__ __forceinline__ unsigned pk2(float lo, float hi) { f32x2_t v = {lo, hi}; bf16x2_t b = __builtin_convertvector(v, bf16x2_t); return __builtin_bit_cast(unsigned, b); }
__device__ __forceinline__ float bf_lo(unsigned u) { return __uint_as_float(u << 16); }
__device__ __forceinline__ float bf_hi(unsigned u) { return __uint_as_float(u & 0xffff0000u); }
__device__ __forceinline__ float bf2f(bf16_t h) { return __uint_as_float(((unsigned)h) << 16); }
__device__ __forceinline__ bf16_t f2bf(float f) { return (bf16_t)(pk2(f, 0.f) & 0xffffu); }
__device__ __forceinline__ void unpack8(uint4 v, float* f) {
  f[0] = bf_lo(v.x); f[1] = bf_hi(v.x); f[2] = bf_lo(v.y); f[3] = bf_hi(v.y);
  f[4] = bf_lo(v.z); f[5] = bf_hi(v.z); f[6] = bf_lo(v.w); f[7] = bf_hi(v.w);
}
__device__ __forceinline__ uint4 pack8(const float* f) { return make_uint4(pk2(f[0], f[1]), pk2(f[2], f[3]), pk2(f[4], f[5]), pk2(f[6], f[7])); }
__device__ __forceinline__ void load8f(const float* p, float* f) {
  float4 a = *(const float4*)p, b = *(const float4*)(p + 4);
  f[0] = a.x; f[1] = a.y; f[2] = a.z; f[3] = a.w; f[4] = b.x; f[5] = b.y; f[6] = b.z; f[7] = b.w;
}
__device__ __forceinline__ void store8f(float* p, const float* f) {
  *(float4*)p = make_float4(f[0], f[1], f[2], f[3]); *(float4*)(p + 4) = make_float4(f[4], f[5], f[6], f[7]);
}
__device__ __forceinline__ float wave_sum(float v) {
#pragma unroll
  for (int o = 1; o < 64; o <<= 1) v += __shfl_xor(v, o);
  return v;
}
__device__ __forceinline__ float dpp_add(float v, const int ctrl_sel) {
  int iv = __float_as_int(v), r;
  if (ctrl_sel == 0) r = __builtin_amdgcn_update_dpp(iv, iv, 0xB1, 0xF, 0xF, false);
  else if (ctrl_sel == 1) r = __builtin_amdgcn_update_dpp(iv, iv, 0x4E, 0xF, 0xF, false);
  else if (ctrl_sel == 2) r = __builtin_amdgcn_update_dpp(iv, iv, 0x141, 0xF, 0xF, false);
  else r = __builtin_amdgcn_update_dpp(iv, iv, 0x140, 0xF, 0xF, false);
  return v + __int_as_float(r);
}
__device__ __forceinline__ float wave_sum_fast(float v) {
  v = dpp_add(v, 0); v = dpp_add(v, 1); v = dpp_add(v, 2); v = dpp_add(v, 3);
  const int iv = __float_as_int(v);
  return (__int_as_float(__builtin_amdgcn_readlane(iv, 0)) + __int_as_float(__builtin_amdgcn_readlane(iv, 16))) +
         (__int_as_float(__builtin_amdgcn_readlane(iv, 32)) + __int_as_float(__builtin_amdgcn_readlane(iv, 48)));
}
__device__ __forceinline__ float grp16_sum(float v) {
#pragma unroll
  for (int o = 1; o < 16; o <<= 1) v += __shfl_xor(v, o);
  return v;
}
__device__ __forceinline__ float sigmoidf_(float x) { return 1.f / (1.f + __expf(-x)); }
__device__ __forceinline__ float siluf_(float x) { return x / (1.f + __expf(-x)); }
__device__ __forceinline__ float softplusf_(float x) { return fmaxf(x, 0.f) + log1pf(__expf(-fabsf(x))); }
__device__ __forceinline__ float geluf_(float x) { return 0.5f * x * (1.f + erff(x * 0.70710678118654752f)); }
__device__ __forceinline__ int seq_row(int t) { return t < NPT ? (t >> 11) : (8 + t - NPT); }
__device__ __forceinline__ const float* xin_row(const Params& p, int t) { return t < NPT ? p.x_prompt + (size_t)t * D : p.x_sample + (size_t)(t - NPT) * D; }
__device__ __forceinline__ bf16x8 ld16(const bf16_t* p) { return *(const bf16x8*)p; }
__device__ __forceinline__ float4 ldnt4(const float* p) { f32x4 v = __builtin_nontemporal_load((const f32x4*)p); return make_float4(v[0], v[1], v[2], v[3]); }
typedef unsigned u32x4_t __attribute__((ext_vector_type(4)));
__device__ __forceinline__ uint4 ldnt_u4(const void* p) { u32x4_t v = __builtin_nontemporal_load((const u32x4_t*)p); return make_uint4(v[0], v[1], v[2], v[3]); }
__device__ __forceinline__ void stnt4(float* p, float4 v) { f32x4 w = {v.x, v.y, v.z, v.w}; __builtin_nontemporal_store(w, (f32x4*)p); }
__device__ __forceinline__ f32x4 mfma16(bf16x8 a, bf16x8 b, f32x4 c) { return __builtin_amdgcn_mfma_f32_16x16x32_bf16(a, b, c, 0, 0, 0); }

__device__ __forceinline__ void transpose_item(const float* W, int K, int N, int Npad, bf16_t* WT, int item, float* tile) {
  const int nb = Npad / 64; const int kb = item / nb, nbi = item % nb; const int k0 = kb * 64, n0 = nbi * 64;
  const int tid = tidx();
#pragma unroll
  for (int i = 0; i < 16; ++i) {
    int kk = i * 4 + (tid >> 6), nn = tid & 63; int n = n0 + nn;
    tile[kk * 65 + nn] = (n < N) ? __builtin_nontemporal_load(W + (size_t)(k0 + kk) * N + n) : 0.f;
  }
  __syncthreads();
  {
    int n = tid >> 2, kc = (tid & 3) * 16;
    unsigned o[8];
#pragma unroll
    for (int j = 0; j < 8; ++j) o[j] = pk2(tile[(kc + 2 * j) * 65 + n], tile[(kc + 2 * j + 1) * 65 + n]);
    uint4* dst = (uint4*)(WT + (size_t)(n0 + n) * K + k0 + kc);
    dst[0] = make_uint4(o[0], o[1], o[2], o[3]); dst[1] = make_uint4(o[4], o[5], o[6], o[7]);
  }
  __syncthreads();
}
__device__ __forceinline__ void cvt_stream(const float* src, bf16_t* dst, size_t n8, size_t gtid, size_t gsz) {
  for (size_t i = gtid; i < n8; i += gsz) { float f[8]; load8f(src + i * 8, f); *(uint4*)(dst + i * 8) = pack8(f); }
}
__device__ __forceinline__ void cvt_stream_fp8(const float* src, unsigned char* dst, size_t n16, float scale, size_t gtid, size_t gsz) {
  const size_t n4 = n16 * 4;
  size_t i = gtid;
  for (; i + 3 * gsz < n4; i += 4 * gsz) {
    float4 f[4];
#pragma unroll
    for (int q = 0; q < 4; ++q) f[q] = ldnt4(src + (i + q * gsz) * 4);
#pragma unroll
    for (int q = 0; q < 4; ++q) {
      int v = __builtin_amdgcn_cvt_pk_fp8_f32(f[q].x * scale, f[q].y * scale, 0, false);
      v = __builtin_amdgcn_cvt_pk_fp8_f32(f[q].z * scale, f[q].w * scale, v, true);
      *(unsigned*)(dst + (i + q * gsz) * 4) = (unsigned)v;
    }
  }
  for (; i < n4; i += gsz) {
    float4 f = ldnt4(src + i * 4);
    int v = __builtin_amdgcn_cvt_pk_fp8_f32(f.x * scale, f.y * scale, 0, false);
    v = __builtin_amdgcn_cvt_pk_fp8_f32(f.z * scale, f.w * scale, v, true);
    *(unsigned*)(dst + i * 4) = (unsigned)v;
  }
}
__device__ __forceinline__ void phase_prep(const Params& p, char* lds) {
  float* tile = (float*)lds;
  char* ws = p.ws;
  const int I_ADA = 16 * 96, I_IN0 = 16 * 106, I_OUT = 32 * 16, I_IN1 = 16 * 96, I_Q = 16 * 32;
  const int NIT = 2 * I_ADA + I_IN0 + I_OUT + I_IN1 + I_OUT + 2 * I_Q;
  for (int it = blockIdx.x; it < NIT; it += gridDim.x) {
    int r = it;
    if (r < I_ADA) { transpose_item(p.ada_w, 1024, 6144, 6144, (bf16_t*)(ws + W_ADA_T), r, tile); continue; } r -= I_ADA;
    if (r < I_ADA) { transpose_item(p.ada_w + (size_t)1024 * 6144, 1024, 6144, 6144, (bf16_t*)(ws + W_ADA_T) + (size_t)6144 * 1024, r, tile); continue; } r -= I_ADA;
    if (r < I_IN0) { transpose_item(p.ab_w_in, 1024, AB_IN, AB_IN_PAD, (bf16_t*)(ws + W_IN0_T), r, tile); continue; } r -= I_IN0;
    if (r < I_OUT) { transpose_item(p.ab_w_out, 2048, 1024, 1024, (bf16_t*)(ws + W_OUT0_T), r, tile); continue; } r -= I_OUT;
    if (r < I_IN1) { transpose_item(p.ret_w_in, 1024, 6144, 6144, (bf16_t*)(ws + W_IN1_T), r, tile); continue; } r -= I_IN1;
    if (r < I_OUT) { transpose_item(p.ret_w_out, 2048, 1024, 1024, (bf16_t*)(ws + W_OUT1_T), r, tile); continue; } r -= I_OUT;
    if (r < I_Q) { transpose_item(p.peer_w_q, 1024, 2048, 2048, (bf16_t*)(ws + W_Q_T), r, tile); continue; } r -= I_Q;
    transpose_item(p.peer_w_q + (size_t)1024 * 2048, 1024, 2048, 2048, (bf16_t*)(ws + W_Q_T) + (size_t)2048 * 1024, r, tile);
  }
  const size_t gtid = (size_t)blockIdx.x * NTHR + tidx(), gsz = (size_t)gridDim.x * NTHR;
  cvt_stream_fp8(p.peer_u, (unsigned char*)(ws + W_U), (size_t)2 * 16384 * 1024 / 16, U_SCALE, gtid, gsz);
  cvt_stream_fp8(p.peer_v, (unsigned char*)(ws + W_V), (size_t)2 * 16384 * 1024 / 16, V_SCALE, gtid, gsz);
  cvt_stream(p.peer_keys, (bf16_t*)(ws + W_KEYS), (size_t)2 * 2 * 128 * 128 / 8, gtid, gsz);
  bf16_t* sc = (bf16_t*)(ws + W_SILUC);
  for (size_t i = gtid; i < (size_t)256 * 1024 / 8; i += gsz) {
    int r = (int)(i >> 7), c8 = (int)(i & 127) * 8;
    float f[8];
    if (r < NSEQ) {
      const float* src = (r < 8) ? p.c_prompt + (size_t)r * D + c8 : p.c_sample + (size_t)(r - 8) * D + c8;
      load8f(src, f);
#pragma unroll
      for (int j = 0; j < 8; ++j) f[j] = siluf_(f[j]);
    } else {
#pragma unroll
      for (int j = 0; j < 8; ++j) f[j] = 0.f;
    }
    *(uint4*)(sc + i * 8) = pack8(f);
  }
}

template <class Epi>
__device__ __forceinline__ void gemm_phase(const bf16_t* __restrict__ A, const bf16_t* __restrict__ Bt, int M, int N, int K, char* lds, Epi epi) {
  const int nM = (M + 127) / 128, nN = (N + 127) / 128;
  const int tid = tidx(), lane = tid & 63, wave = tid >> 6, wr = wave >> 1, wc = wave & 1, fr = lane & 15, fq = lane >> 4;
  char* As = lds; char* Bs = lds + 16384;
  const int sc = tid & 7, sr = tid >> 3;
  for (int tile = blockIdx.x; tile < nM * nN; tile += gridDim.x) {
    const int tm = tile / nN, tn = tile % nN; const int m0 = tm * 128, n0 = tn * 128;
    f32x4 acc[4][4];
#pragma unroll
    for (int m = 0; m < 4; ++m)
#pragma unroll
      for (int n = 0; n < 4; ++n) acc[m][n] = (f32x4){0.f, 0.f, 0.f, 0.f};
    const bf16_t* Ap = A + (size_t)(m0 + sr) * K + sc * 8;
    const bf16_t* Bp = Bt + (size_t)(n0 + sr) * K + sc * 8;
    const size_t K32 = (size_t)32 * K;
    uint4 ra0 = *(const uint4*)(Ap), ra1 = *(const uint4*)(Ap + K32), ra2 = *(const uint4*)(Ap + 2 * K32), ra3 = *(const uint4*)(Ap + 3 * K32);
    uint4 rb0 = *(const uint4*)(Bp), rb1 = *(const uint4*)(Bp + K32), rb2 = *(const uint4*)(Bp + 2 * K32), rb3 = *(const uint4*)(Bp + 3 * K32);
    const int off0 = sr * 128 + ((sc ^ (sr & 7)) << 4);
    for (int k0 = 0; k0 < K; k0 += 64) {
      __syncthreads();
      *(uint4*)(As + off0) = ra0; *(uint4*)(As + off0 + 4096) = ra1; *(uint4*)(As + off0 + 8192) = ra2; *(uint4*)(As + off0 + 12288) = ra3;
      *(uint4*)(Bs + off0) = rb0; *(uint4*)(Bs + off0 + 4096) = rb1; *(uint4*)(Bs + off0 + 8192) = rb2; *(uint4*)(Bs + off0 + 12288) = rb3;
      __syncthreads();
      {
        const int kn = (k0 + 64 < K) ? k0 + 64 : k0;
        ra0 = *(const uint4*)(Ap + kn); ra1 = *(const uint4*)(Ap + K32 + kn); ra2 = *(const uint4*)(Ap + 2 * K32 + kn); ra3 = *(const uint4*)(Ap + 3 * K32 + kn);
        rb0 = *(const uint4*)(Bp + kn); rb1 = *(const uint4*)(Bp + K32 + kn); rb2 = *(const uint4*)(Bp + 2 * K32 + kn); rb3 = *(const uint4*)(Bp + 3 * K32 + kn);
      }
#pragma unroll
      for (int kk = 0; kk < 2; ++kk) {
        bf16x8 af[4], bfv[4];
#pragma unroll
        for (int m = 0; m < 4; ++m) { int row = wr * 64 + m * 16 + fr; af[m] = *(const bf16x8*)(As + row * 128 + (((kk * 4 + fq) ^ (row & 7)) << 4)); }
#pragma unroll
        for (int n = 0; n < 4; ++n) { int row = wc * 64 + n * 16 + fr; bfv[n] = *(const bf16x8*)(Bs + row * 128 + (((kk * 4 + fq) ^ (row & 7)) << 4)); }
        __builtin_amdgcn_s_setprio(1);
#pragma unroll
        for (int m = 0; m < 4; ++m)
#pragma unroll
          for (int n = 0; n < 4; ++n) acc[m][n] = mfma16(bfv[n], af[m], acc[m][n]);
        __builtin_amdgcn_s_setprio(0);
      }
    }
#pragma unroll
    for (int m = 0; m < 4; ++m)
#pragma unroll
      for (int n = 0; n < 4; ++n) epi(m0 + wr * 64 + m * 16 + fr, n0 + wc * 64 + n * 16 + fq * 4, acc[m][n]);
  }
}

struct EpiMod { float* mod; const float* bias;
  __device__ __forceinline__ void operator()(int r, int c, f32x4 v) const {
    if (r < NSEQ) { float4 b = *(const float4*)(bias + c); *(float4*)(mod + (size_t)r * 12288 + c) = make_float4(v[0] + b.x, v[1] + b.y, v[2] + b.z, v[3] + b.w); } } };
struct EpiProj0 { bf16_t* pre; bf16_t* gz;
  __device__ __forceinline__ void operator()(int r, int c, f32x4 v) const {
    uint2 o = make_uint2(pk2(v[0], v[1]), pk2(v[2], v[3]));
    if (c < CONV_CH) *(uint2*)(pre + (size_t)r * CONV_CH + c) = o;
    else if (c < AB_IN) *(uint2*)(gz + (size_t)r * GZ_W + (c - CONV_CH)) = o; } };
struct EpiBf { bf16_t* dst; int ld;
  __device__ __forceinline__ void operator()(int r, int c, f32x4 v) const { *(uint2*)(dst + (size_t)r * ld + c) = make_uint2(pk2(v[0], v[1]), pk2(v[2], v[3])); } };
struct EpiRes { const float* xp; const float* xs; const float* gate;   float* xws; int from_input;
  __device__ __forceinline__ void operator()(int r, int c, f32x4 v) const {
    const float* xr = from_input ? (r < NPT ? xp + (size_t)r * D : xs + (size_t)(r - NPT) * D) : xws + (size_t)r * D;
    float4 x = *(const float4*)(xr + c); float4 g = *(const float4*)(gate + (size_t)seq_row(r) * 12288 + c);
    *(float4*)(xws + (size_t)r * D + c) = make_float4(x.x + g.x * v[0], x.y + g.y * v[1], x.z + g.z * v[2], x.w + g.w * v[3]); } };

__device__ __forceinline__ void adaln_write(const float* xv  , float ss, const float* g, const float* sc, const float* sh, bf16_t* orow, int lane) {
  const float rstd = rsqrtf(ss * (1.f / D) + 1e-6f);
#pragma unroll
  for (int j = 0; j < 2; ++j) {
    const int c = j * 512 + lane * 8;
    float gg[8], s1[8], s2[8], o[8];
    load8f(g + c, gg); load8f(sc + c, s1); load8f(sh + c, s2);
#pragma unroll
    for (int i = 0; i < 8; ++i) o[i] = xv[j * 8 + i] * rstd * gg[i] * (1.f + s1[i]) + s2[i];
    *(uint4*)(orow + c) = pack8(o);
  }
}
__device__ __forceinline__ void phase_adaln(const Params& p, int layer, int which, bool from_input) {
  const int lane = tidx() & 63, wave = tidx() >> 6;
  const float* mod = (const float*)(p.ws + W_MOD);
  bf16_t* hm = (bf16_t*)(p.ws + W_HM);
  const float* xws = (const float*)(p.ws + W_X);
  const float* g = (which == 0 ? p.norm1_g : p.norm2_g) + layer * D;
  for (int t = blockIdx.x * 4 + wave; t < NTOK; t += gridDim.x * 4) {
    const float* xr = from_input ? xin_row(p, t) : xws + (size_t)t * D;
    float xv[16]; load8f(xr + lane * 8, xv); load8f(xr + 512 + lane * 8, xv + 8);
    float ss = 0.f;
#pragma unroll
    for (int i = 0; i < 16; ++i) ss += xv[i] * xv[i];
    ss = wave_sum(ss);
    const float* mr = mod + (size_t)seq_row(t) * 12288 + layer * 6144 + which * 3072;
    adaln_write(xv, ss, g, mr + 1024, mr, hm + (size_t)t * D, lane);
  }
}

__device__ __forceinline__ void phase_conv(const Params& p) {
  const int lane = tidx() & 63, wave = tidx() >> 6;
  const bf16_t* pre = (const bf16_t*)(p.ws + W_PRE);
  const bf16_t* gz = (const bf16_t*)(p.ws + W_GZ);
  bf16_t* xbc = (bf16_t*)(p.ws + W_XBC);
  float* scal = (float*)(p.ws + W_SCAL);
  for (int t = blockIdx.x * 4 + wave; t < NTOK; t += gridDim.x * 4) {
    const bool smp = t >= NPT; const int b = smp ? t - NPT : (t >> 11); const int l = smp ? 0 : (t & 2047);
#pragma unroll 3
    for (int ch = 0; ch < 9; ++ch) {
      const int c = ch * 512 + lane * 8;
      float cur[8], p1[8], p2[8], p3[8];
      unpack8(*(const uint4*)(pre + (size_t)t * CONV_CH + c), cur);
      if (smp) {
        const float* st = p.state_conv + (size_t)b * 3 * CONV_CH + c;
        load8f(st + 2 * CONV_CH, p1); load8f(st + CONV_CH, p2); load8f(st, p3);
      } else {
        if (l >= 1) unpack8(*(const uint4*)(pre + (size_t)(t - 1) * CONV_CH + c), p1); else { for (int i = 0; i < 8; ++i) p1[i] = 0.f; }
        if (l >= 2) unpack8(*(const uint4*)(pre + (size_t)(t - 2) * CONV_CH + c), p2); else { for (int i = 0; i < 8; ++i) p2[i] = 0.f; }
        if (l >= 3) unpack8(*(const uint4*)(pre + (size_t)(t - 3) * CONV_CH + c), p3); else { for (int i = 0; i < 8; ++i) p3[i] = 0.f; }
      }
      float w0[8], w1[8], w2[8], w3[8], bb[8], y[8];
      load8f(p.ab_conv_w + c, w0); load8f(p.ab_conv_w + CONV_CH + c, w1); load8f(p.ab_conv_w + 2 * CONV_CH + c, w2); load8f(p.ab_conv_w + 3 * CONV_CH + c, w3);
      load8f(p.ab_conv_b + c, bb);
      float ss = 0.f;
#pragma unroll
      for (int i = 0; i < 8; ++i) { float v = bb[i] + w3[i] * cur[i] + w2[i] * p1[i] + w1[i] * p2[i] + w0[i] * p3[i]; v = siluf_(v); y[i] = v; ss += v * v; }
      if (ch < 4) {
        ss = grp16_sum(ss);
        float s = rsqrtf(ss + 1e-6f) * (ch < 2 ? 0.08838834764831845f : 1.f);
#pragma unroll
        for (int i = 0; i < 8; ++i) y[i] *= s;
      }
      *(uint4*)(xbc + (size_t)t * CONV_CH + c) = pack8(y);
      if (smp) {
        float* o = p.out + O_CONVS + (size_t)b * 3 * CONV_CH + c;
        store8f(o, p2); store8f(o + CONV_CH, p1); store8f(o + 2 * CONV_CH, cur);
      } else if (l >= SEQ - 3) {
        store8f(p.out + O_CONVP + ((size_t)b * 3 + (l - (SEQ - 3))) * CONV_CH + c, cur);
      }
    }
    if (lane < 32) {
      const bf16_t* gr = gz + (size_t)t * GZ_W + 2048;
      float v;
      if (lane < 8) { v = sigmoidf_(bf2f(gr[lane])); }
      else if (lane < 16) { int h = lane - 8; v = -__expf(p.gdn_a_log[h]) * softplusf_(bf2f(gr[8 + h]) + p.gdn_dt_bias[h]); }
      else { int h = lane - 16; v = softplusf_(bf2f(gr[16 + h]) + p.ssm_dt_bias[h]); }
      scal[(size_t)t * 48 + lane] = v;
      if (lane >= 16) { int h = lane - 16; scal[(size_t)t * 48 + 32 + h] = -v * __expf(p.ssm_a_log[h]); }
    }
  }
}

template <int DK>
__device__ __forceinline__ void qk_blobs(const bf16_t* qS, const bf16_t* kS, const float* gcS, const float* jsS, const float* betaS,
                                         bf16_t* Qg, bf16_t* KdT, bf16_t* QKd, float* Lout) {
  constexpr int LD = DK + 8, KS = DK / 32;
  const int tid = tidx(), lane = tid & 63, w = tid >> 6, fr = lane & 15, fq = lane >> 4;
  const int i = 16 * w + fr; const float gci = gcS[i];
#pragma unroll
  for (int nt = 0; nt < 4; ++nt) {
    f32x4 acc = (f32x4){0.f, 0.f, 0.f, 0.f}, acc2 = (f32x4){0.f, 0.f, 0.f, 0.f};
#pragma unroll
    for (int ks = 0; ks < KS; ++ks) {
      bf16x8 a = *(const bf16x8*)(kS + (nt * 16 + fr) * LD + ks * 32 + fq * 8);
      bf16x8 bq = *(const bf16x8*)(qS + i * LD + ks * 32 + fq * 8);
      acc = mfma16(a, bq, acc);
      if (Lout) { bf16x8 bk = *(const bf16x8*)(kS + i * LD + ks * 32 + fq * 8); acc2 = mfma16(a, bk, acc2); }
    }
    float o[4], lo[4];
#pragma unroll
    for (int jj = 0; jj < 4; ++jj) {
      const int j = nt * 16 + fq * 4 + jj;
      const float dcy = (j <= i) ? __expf(gci - gcS[j]) : 0.f;
      o[jj] = (j <= i) ? acc[jj] * dcy * jsS[j] : 0.f;
      lo[jj] = (j < i) ? acc2[jj] * dcy * betaS[i] : 0.f;
    }
    *(uint2*)(QKd + i * 64 + nt * 16 + fq * 4) = make_uint2(pk2(o[0], o[1]), pk2(o[2], o[3]));
    if (Lout) *(float4*)(Lout + i * 68 + nt * 16 + fq * 4) = make_float4(lo[0], lo[1], lo[2], lo[3]);
  }
  for (int idx = tid; idx < 64 * (DK / 8); idx += NTHR) {
    const int r = idx / (DK / 8), c8 = idx % (DK / 8);
    float f[8]; unpack8(*(const uint4*)(qS + r * LD + c8 * 8), f);
    const float s = __expf(gcS[r]);
#pragma unroll
    for (int q = 0; q < 8; ++q) f[q] *= s;
    *(uint4*)(Qg + r * DK + c8 * 8) = pack8(f);
  }
  const float glast = gcS[63];
  for (int idx = tid; idx < DK * 8; idx += NTHR) {
    const int d = idx >> 3, j0 = (idx & 7) * 8;
    float f[8];
#pragma unroll
    for (int q = 0; q < 8; ++q) f[q] = bf2f(kS[(j0 + q) * LD + d]) * jsS[j0 + q] * __expf(glast - gcS[j0 + q]);
    *(uint4*)(KdT + d * 64 + j0) = pack8(f);
  }
}

__device__ __forceinline__ float wave_incl_scan(float v, int lane) {
#pragma unroll
  for (int o = 1; o < 64; o <<= 1) { float u = __shfl_up(v, o); if (lane >= o) v += u; }
  return v;
}

__device__ __forceinline__ void gdn_prep_item(const Params& p, int it, char* lds) {
  constexpr int LD = 136;
  bf16_t* qS = (bf16_t*)lds; bf16_t* kS = qS + 64 * LD; float* L = (float*)(kS + 64 * LD);
  float* gcS = L + 64 * 68; float* jsS = gcS + 64; float* betaS = jsS + 64;
  const int tid = tidx(), lane = tid & 63;
  const int bh = it >> 5, c = it & 31, b = bh >> 3, h = bh & 7; const int t0 = b * SEQ + c * 64;
  const bf16_t* xbc = (const bf16_t*)(p.ws + W_XBC);
  const float* scal = (const float*)(p.ws + W_SCAL);
  char* blob = p.ws + W_GDNB + (size_t)it * GDN_BLOB;
  bf16_t* Qg = (bf16_t*)blob; bf16_t* KdT = Qg + 64 * 128; bf16_t* QKd = KdT + 128 * 64; bf16_t* Wn = QKd + 4096; bf16_t* U0 = Wn + 64 * 128;
  for (int idx = tid; idx < 64 * 16; idx += NTHR) {
    const int r = idx >> 4, c8 = (idx & 15) * 8;
    *(uint4*)(qS + r * LD + c8) = *(const uint4*)(xbc + (size_t)(t0 + r) * CONV_CH + h * 128 + c8);
    *(uint4*)(kS + r * LD + c8) = *(const uint4*)(xbc + (size_t)(t0 + r) * CONV_CH + 1024 + h * 128 + c8);
  }
  if (tid < 64) {
    float g = scal[(size_t)(t0 + tid) * 48 + 8 + h];
    float gc = wave_incl_scan(g, lane);
    gcS[tid] = gc; jsS[tid] = 1.f; betaS[tid] = scal[(size_t)(t0 + tid) * 48 + h];
    if (tid == 63) ((float*)(p.ws + W_DEC))[it] = __expf(gc);
  }
  __syncthreads();
  qk_blobs<128>(qS, kS, gcS, jsS, betaS, Qg, KdT, QKd, L);
  __syncthreads();
  float x[64];
  if (tid < 128) {
#pragma unroll
    for (int i = 0; i < 64; ++i) x[i] = bf2f(xbc[(size_t)(t0 + i) * CONV_CH + 2048 + h * 128 + tid]) * betaS[i];
  } else {
#pragma unroll
    for (int i = 0; i < 64; ++i) x[i] = bf2f(kS[i * LD + (tid - 128)]) * betaS[i] * __expf(gcS[i]);
  }
#pragma unroll
  for (int i = 1; i < 64; ++i) {
    float s = x[i];
#pragma unroll
    for (int j4 = 0; j4 < (i + 3) / 4; ++j4) {
      float4 l = *(const float4*)(L + i * 68 + j4 * 4);
      if (j4 * 4 + 0 < i) s -= l.x * x[j4 * 4 + 0];
      if (j4 * 4 + 1 < i) s -= l.y * x[j4 * 4 + 1];
      if (j4 * 4 + 2 < i) s -= l.z * x[j4 * 4 + 2];
      if (j4 * 4 + 3 < i) s -= l.w * x[j4 * 4 + 3];
    }
    x[i] = s;
  }
  if (tid < 128) {
#pragma unroll
    for (int i = 0; i < 64; ++i) U0[i * 128 + tid] = f2bf(x[i]);
  } else {
#pragma unroll
    for (int i = 0; i < 64; ++i) Wn[i * 128 + (tid - 128)] = f2bf(-x[i]);
  }
  __syncthreads();
#ifdef CHK_PREP
  { __threadfence(); unsigned xx = 0; const unsigned* wp = (const unsigned*)blob;
    for (int i = tid; i < (int)GDN_BLOB / 4; i += NTHR) xx ^= wp[i];
    p.out[O_GDNP + (size_t)it * 512 + tid] = (float)(xx & 0xFFFF); p.out[O_GDNP + (size_t)it * 512 + 256 + tid] = (float)(xx >> 16); }
#endif
}

__device__ __forceinline__ void ssd_prep_item(const Params& p, int it, char* lds) {
  constexpr int LD = 136;
  bf16_t* qS = (bf16_t*)lds; bf16_t* kS = qS + 64 * LD; float* gcS = (float*)(kS + 64 * LD); float* jsS = gcS + 64; float* betaS = jsS + 64;
  const int tid = tidx(), lane = tid & 63;
  const int bh = it >> 5, c = it & 31, b = bh >> 4, h = bh & 15, g = h >> 3; const int t0 = b * SEQ + c * 64;
  const bf16_t* xbc = (const bf16_t*)(p.ws + W_XBC);
  const float* scal = (const float*)(p.ws + W_SCAL);
  char* blob = p.ws + W_SSDB + (size_t)it * SSD_BLOB;
  bf16_t* Qg = (bf16_t*)blob; bf16_t* KdT = Qg + 64 * 128; bf16_t* QKd = KdT + 128 * 64;
  for (int idx = tid; idx < 64 * 16; idx += NTHR) {
    const int r = idx >> 4, c8 = (idx & 15) * 8;
    *(uint4*)(qS + r * LD + c8) = *(const uint4*)(xbc + (size_t)(t0 + r) * CONV_CH + 4352 + g * 128 + c8);
    *(uint4*)(kS + r * LD + c8) = *(const uint4*)(xbc + (size_t)(t0 + r) * CONV_CH + 4096 + g * 128 + c8);
  }
  if (tid < 64) {
    float la = scal[(size_t)(t0 + tid) * 48 + 32 + h];
    float gc = wave_incl_scan(la, lane);
    gcS[tid] = gc; jsS[tid] = scal[(size_t)(t0 + tid) * 48 + 16 + h]; betaS[tid] = 0.f;
    if (tid == 63) ((float*)(p.ws + W_DEC))[2048 + it] = __expf(gc);
  }
  __syncthreads();
  qk_blobs<128>(qS, kS, gcS, jsS, betaS, Qg, KdT, QKd, nullptr);
  __syncthreads();
}

__device__ __forceinline__ void rope_sincos(float pos, int dd, float& s, float& c) {
  const float inv = exp2f(-(float)dd * 0.10381025296523008f);
  const float ang = pos * inv;
  double r = (double)ang * 0.15915494309189535; r -= floor(r);
  const float fr = (float)r;
  s = __builtin_amdgcn_sinf(fr); c = __builtin_amdgcn_cosf(fr);
}

__device__ __forceinline__ void ret_prep_item(const Params& p, int it, char* lds) {
  constexpr int LD = 264;
  bf16_t* qS = (bf16_t*)lds; bf16_t* kS = qS + 64 * LD; float* gcS = (float*)(kS + 64 * LD); float* jsS = gcS + 64; float* betaS = jsS + 64;
  const int tid = tidx();
  const int bh = it >> 5, c = it & 31, b = bh >> 2, h = bh & 3; const int t0 = b * SEQ + c * 64;
  const bf16_t* pj = (const bf16_t*)(p.ws + W_PROJ1);
  char* blob = p.ws + W_RETB + (size_t)it * RET_BLOB;
  bf16_t* Qg = (bf16_t*)blob; bf16_t* KdT = Qg + 64 * 256; bf16_t* QKd = KdT + 256 * 64;
  for (int idx = tid; idx < 64 * 16; idx += NTHR) {
    const int r = idx >> 4, d8 = (idx & 15) * 8; const float pos = (float)(c * 64 + r);
    float q1[8], q2[8], k1[8], k2[8], oq1[8], oq2[8], ok1[8], ok2[8];
    const bf16_t* row = pj + (size_t)(t0 + r) * RET_IN + h * 256;
    unpack8(*(const uint4*)(row + d8), q1); unpack8(*(const uint4*)(row + 128 + d8), q2);
    unpack8(*(const uint4*)(row + 1024 + d8), k1); unpack8(*(const uint4*)(row + 1024 + 128 + d8), k2);
#pragma unroll
    for (int q = 0; q < 8; ++q) {
      float s, cs; rope_sincos(pos, d8 + q, s, cs);
      oq1[q] = q1[q] * cs - q2[q] * s; oq2[q] = q1[q] * s + q2[q] * cs;
      ok1[q] = (k1[q] * cs - k2[q] * s) * 0.0625f; ok2[q] = (k1[q] * s + k2[q] * cs) * 0.0625f;
    }
    *(uint4*)(qS + r * LD + d8) = pack8(oq1); *(uint4*)(qS + r * LD + 128 + d8) = pack8(oq2);
    *(uint4*)(kS + r * LD + d8) = pack8(ok1); *(uint4*)(kS + r * LD + 128 + d8) = pack8(ok2);
  }
  if (tid < 64) {
    const float lg = log1pf(-exp2f(-5.f - (float)h));
    gcS[tid] = (float)(tid + 1) * lg; jsS[tid] = 1.f; betaS[tid] = 0.f;
    if (tid == 63) ((float*)(p.ws + W_DEC))[6144 + it] = __expf(64.f * lg);
  }
  __syncthreads();
  qk_blobs<256>(qS, kS, gcS, jsS, betaS, Qg, KdT, QKd, nullptr);
  __syncthreads();
}

__device__ __forceinline__ void gdn_sample_item(const Params& p, int it, char* lds) {
  float* ks = (float*)lds; float* qs = ks + 128; float* vs = qs + 128; float* red = vs + 128;
  const int tid = tidx(), lane = tid & 63;
  const int b = it >> 3, h = it & 7; const int t = NPT + b;
  const bf16_t* xr = (const bf16_t*)(p.ws + W_XBC) + (size_t)t * CONV_CH;
  const float* scal = (const float*)(p.ws + W_SCAL) + (size_t)t * 48;
  if (tid < 128) { qs[tid] = bf2f(xr[h * 128 + tid]); ks[tid] = bf2f(xr[1024 + h * 128 + tid]); vs[tid] = bf2f(xr[2048 + h * 128 + tid]); }
  const float beta = scal[h], a = __expf(scal[8 + h]);
  __syncthreads();
  const int e4 = (tid & 31) * 4, dg = tid >> 5;
  const float* S0 = p.state_gdn + (size_t)(b * 8 + h) * 16384;
  float4 S[16]; float4 kS4 = make_float4(0, 0, 0, 0), qS4 = make_float4(0, 0, 0, 0);
#pragma unroll
  for (int i = 0; i < 16; ++i) {
    const int d = dg + 8 * i; S[i] = ldnt4(S0 + d * 128 + e4);
    const float kd = ks[d], qd = qs[d];
    kS4.x += kd * S[i].x; kS4.y += kd * S[i].y; kS4.z += kd * S[i].z; kS4.w += kd * S[i].w;
    qS4.x += qd * S[i].x; qS4.y += qd * S[i].y; qS4.z += qd * S[i].z; qS4.w += qd * S[i].w;
  }
  *(float4*)(red + dg * 128 + e4) = kS4; *(float4*)(red + 1024 + dg * 128 + e4) = qS4;
  float qk = wave_sum(qs[lane] * ks[lane] + qs[lane + 64] * ks[lane + 64]);
  __syncthreads();
  float4 kf = make_float4(0, 0, 0, 0), qf = make_float4(0, 0, 0, 0);
#pragma unroll
  for (int g = 0; g < 8; ++g) {
    float4 u = *(const float4*)(red + g * 128 + e4), v = *(const float4*)(red + 1024 + g * 128 + e4);
    kf.x += u.x; kf.y += u.y; kf.z += u.z; kf.w += u.w; qf.x += v.x; qf.y += v.y; qf.z += v.z; qf.w += v.w;
  }
  const float4 v4 = *(const float4*)(vs + e4);
  float4 u4 = make_float4(beta * (v4.x - a * kf.x), beta * (v4.y - a * kf.y), beta * (v4.z - a * kf.z), beta * (v4.w - a * kf.w));
  float* So = p.out + O_GDNS + (size_t)(b * 8 + h) * 16384;
#pragma unroll
  for (int i = 0; i < 16; ++i) {
    const int d = dg + 8 * i; const float kd = ks[d];
    stnt4(So + d * 128 + e4, make_float4(a * S[i].x + kd * u4.x, a * S[i].y + kd * u4.y, a * S[i].z + kd * u4.z, a * S[i].w + kd * u4.w));
  }
  if (dg == 0) {
    bf16_t* o = (bf16_t*)(p.ws + W_ORAW) + (size_t)t * 2048 + h * 128 + e4;
    *(uint2*)o = make_uint2(pk2(a * qf.x + qk * u4.x, a * qf.y + qk * u4.y), pk2(a * qf.z + qk * u4.z, a * qf.w + qk * u4.w));
  }
  __syncthreads();
}
__device__ __forceinline__ void ssd_sample_item(const Params& p, int it, char* lds) {
  float* ks = (float*)lds; float* qs = ks + 128; float* vs = qs + 128; float* red = vs + 64;
  const int tid = tidx();
  const int b = it >> 4, h = it & 15, g = h >> 3; const int t = NPT + b;
  const bf16_t* xr = (const bf16_t*)(p.ws + W_XBC) + (size_t)t * CONV_CH;
  const float* scal = (const float*)(p.ws + W_SCAL) + (size_t)t * 48;
  const float dt = scal[16 + h], a = __expf(scal[32 + h]);
  if (tid < 128) { ks[tid] = bf2f(xr[4096 + g * 128 + tid]) * dt; qs[tid] = bf2f(xr[4352 + g * 128 + tid]); }
  if (tid < 64) vs[tid] = bf2f(xr[3072 + h * 64 + tid]);
  __syncthreads();
  const int p4 = (tid & 15) * 4, ng = tid >> 4;
  const float* S0 = p.state_ssm + (size_t)(b * 16 + h) * 8192;
  float* So = p.out + O_SSMS + (size_t)(b * 16 + h) * 8192;
  const float4 v4 = *(const float4*)(vs + p4);
  float4 o4 = make_float4(0, 0, 0, 0);
#pragma unroll
  for (int i = 0; i < 8; ++i) {
    const int n = ng + 16 * i; float4 s = ldnt4(S0 + n * 64 + p4);
    const float kn = ks[n], qn = qs[n];
    s.x = a * s.x + kn * v4.x; s.y = a * s.y + kn * v4.y; s.z = a * s.z + kn * v4.z; s.w = a * s.w + kn * v4.w;
    stnt4(So + n * 64 + p4, s);
    o4.x += qn * s.x; o4.y += qn * s.y; o4.z += qn * s.z; o4.w += qn * s.w;
  }
  *(float4*)(red + ng * 64 + p4) = o4;
  __syncthreads();
  if (tid < 16) {
    float4 s = make_float4(0, 0, 0, 0);
#pragma unroll
    for (int gg = 0; gg < 16; ++gg) { float4 u = *(const float4*)(red + gg * 64 + tid * 4); s.x += u.x; s.y += u.y; s.z += u.z; s.w += u.w; }
    bf16_t* o = (bf16_t*)(p.ws + W_ORAW) + (size_t)t * 2048 + 1024 + h * 64 + tid * 4;
    *(uint2*)o = make_uint2(pk2(s.x, s.y), pk2(s.z, s.w));
  }
  __syncthreads();
}
__device__ __forceinline__ void ret_sample_item(const Params& p, int it, char* lds) {
  float* ks = (float*)lds; float* qs = ks + 256; float* vs = qs + 256; float* red = vs + 128;
  const int tid = tidx();
  const int sl = it & 3, bh = it >> 2, b = bh >> 2, h = bh & 3; const int t = NPT + b; const int e0 = sl * 128;
  const bf16_t* row = (const bf16_t*)(p.ws + W_PROJ1) + (size_t)t * RET_IN;
  {
    const int d = tid, dd = d & 127;
    float s, c; rope_sincos(16384.f, dd, s, c);
    const float q1 = bf2f(row[h * 256 + dd]), q2 = bf2f(row[h * 256 + 128 + dd]);
    const float k1 = bf2f(row[1024 + h * 256 + dd]), k2 = bf2f(row[1024 + h * 256 + 128 + dd]);
    qs[d] = d < 128 ? q1 * c - q2 * s : q1 * s + q2 * c;
    ks[d] = (d < 128 ? k1 * c - k2 * s : k1 * s + k2 * c) * 0.0625f;
    if (tid < 128) vs[tid] = bf2f(row[2048 + h * 512 + e0 + tid]);
  }
  __syncthreads();
  const float gamma = 1.f - exp2f(-5.f - (float)h);
  const int e4 = (tid & 31) * 4, dg = tid >> 5;
  const float* S0 = p.state_ret + (size_t)(b * 4 + h) * 131072 + e0;
  float* So = p.out + O_RETS + (size_t)(b * 4 + h) * 131072 + e0;
  const float4 v4 = *(const float4*)(vs + e4);
  float4 o4 = make_float4(0, 0, 0, 0);
#pragma unroll 8
  for (int i = 0; i < 32; ++i) {
    const int d = dg + 8 * i; float4 s = ldnt4(S0 + (size_t)d * 512 + e4);
    const float kn = ks[d], qn = qs[d];
    s.x = gamma * s.x + kn * v4.x; s.y = gamma * s.y + kn * v4.y; s.z = gamma * s.z + kn * v4.z; s.w = gamma * s.w + kn * v4.w;
    stnt4(So + (size_t)d * 512 + e4, s);
    o4.x += qn * s.x; o4.y += qn * s.y; o4.z += qn * s.z; o4.w += qn * s.w;
  }
  *(float4*)(red + dg * 128 + e4) = o4;
  __syncthreads();
  if (tid < 32) {
    float4 s = make_float4(0, 0, 0, 0);
#pragma unroll
    for (int gg = 0; gg < 8; ++gg) { float4 u = *(const float4*)(red + gg * 128 + tid * 4); s.x += u.x; s.y += u.y; s.z += u.z; s.w += u.w; }
    bf16_t* o = (bf16_t*)(p.ws + W_ORAW) + (size_t)t * 2048 + h * 512 + e0 + tid * 4;
    *(uint2*)o = make_uint2(pk2(s.x, s.y), pk2(s.z, s.w));
  }
  __syncthreads();
}

__device__ __forceinline__ void lds_barrier() { asm volatile("s_waitcnt lgkmcnt(0)\n\ts_barrier" ::: "memory"); }
template <int DK, int DVS, bool HAS_W>
__device__ __forceinline__ void scan_item(const char* blob0, size_t blob_stride, const float* dec,
                                          const bf16_t* U0, size_t u_stride, size_t u_cstride,
                                          bf16_t* O, size_t o_stride, float* Sout, int s_stride, char* lds) {
  constexpr int NT = DVS / 16, MT = DK / 64, KS = DK / 32, LS = DK + 8, LU = 72;
  bf16_t* Sbt = (bf16_t*)lds; bf16_t* Ubt = Sbt + DVS * LS;
  const int tid = tidx(), lane = tid & 63, w = tid >> 6, fr = lane & 15, fq = lane >> 4;
  __builtin_amdgcn_s_setprio(2);
  f32x4 Sacc[MT][NT];
#pragma unroll
  for (int m = 0; m < MT; ++m)
#pragma unroll
    for (int n = 0; n < NT; ++n) Sacc[m][n] = (f32x4){0.f, 0.f, 0.f, 0.f};
  for (int i = tid; i < DVS * LS / 8; i += NTHR) ((uint4*)Sbt)[i] = make_uint4(0, 0, 0, 0);
  bf16_t u0r[NT][4]; bf16x8 wn[KS];
  {
    const bf16_t* Wn0 = (const bf16_t*)blob0 + 64 * DK + DK * 64 + 4096;
#pragma unroll
    for (int n = 0; n < NT; ++n)
#pragma unroll
      for (int jj = 0; jj < 4; ++jj) u0r[n][jj] = U0[(size_t)(16 * w + fq * 4 + jj) * u_stride + n * 16 + fr];
    if (HAS_W) {
#pragma unroll
      for (int ks = 0; ks < KS; ++ks) wn[ks] = ld16(Wn0 + (16 * w + fr) * DK + ks * 32 + fq * 8);
    }
  }
  __syncthreads();
#pragma unroll 1
  for (int c = 0; c < 32; ++c) {
    const bf16_t* Qg = (const bf16_t*)(blob0 + (size_t)c * blob_stride);
    const bf16_t* KdT = Qg + 64 * DK; const bf16_t* QKd = KdT + DK * 64;
    bf16x8 qg[KS], qkd[2], kdt[MT][2];
#pragma unroll
    for (int ks = 0; ks < KS; ++ks) qg[ks] = ld16(Qg + (16 * w + fr) * DK + ks * 32 + fq * 8);
#pragma unroll
    for (int ks = 0; ks < 2; ++ks) qkd[ks] = ld16(QKd + (16 * w + fr) * 64 + ks * 32 + fq * 8);
#pragma unroll
    for (int m = 0; m < MT; ++m)
#pragma unroll
      for (int ks = 0; ks < 2; ++ks) kdt[m][ks] = ld16(KdT + (w * (DK / 4) + m * 16 + fr) * 64 + ks * 32 + fq * 8);
    const float dc = dec[c];
    f32x4 Uacc[NT];
#pragma unroll
    for (int n = 0; n < NT; ++n)
#pragma unroll
      for (int jj = 0; jj < 4; ++jj) Uacc[n][jj] = bf2f(u0r[n][jj]);
    if (HAS_W) {
#pragma unroll
      for (int ks = 0; ks < KS; ++ks) {
#pragma unroll
        for (int n = 0; n < NT; ++n) { bf16x8 bb = *(const bf16x8*)(Sbt + (n * 16 + fr) * LS + ks * 32 + fq * 8); Uacc[n] = mfma16(wn[ks], bb, Uacc[n]); }
      }
    }
    {
      const int cn = (c + 1 < 32) ? c + 1 : c;
      const bf16_t* Wnn = (const bf16_t*)(blob0 + (size_t)cn * blob_stride) + 64 * DK + DK * 64 + 4096;
#pragma unroll
      for (int n = 0; n < NT; ++n)
#pragma unroll
        for (int jj = 0; jj < 4; ++jj) u0r[n][jj] = U0[(size_t)cn * u_cstride + (size_t)(16 * w + fq * 4 + jj) * u_stride + n * 16 + fr];
      if (HAS_W) {
#pragma unroll
        for (int ks = 0; ks < KS; ++ks) wn[ks] = ld16(Wnn + (16 * w + fr) * DK + ks * 32 + fq * 8);
      }
    }
#pragma unroll
    for (int n = 0; n < NT; ++n) *(uint2*)(Ubt + (n * 16 + fr) * LU + 16 * w + fq * 4) = make_uint2(pk2(Uacc[n][0], Uacc[n][1]), pk2(Uacc[n][2], Uacc[n][3]));
    lds_barrier();
    f32x4 Oacc[NT];
#pragma unroll
    for (int n = 0; n < NT; ++n) Oacc[n] = (f32x4){0.f, 0.f, 0.f, 0.f};
#pragma unroll
    for (int ks = 0; ks < KS; ++ks) {
#pragma unroll
      for (int n = 0; n < NT; ++n) { bf16x8 a = *(const bf16x8*)(Sbt + (n * 16 + fr) * LS + ks * 32 + fq * 8); Oacc[n] = mfma16(a, qg[ks], Oacc[n]); }
    }
    bf16x8 ub[2][NT];
#pragma unroll
    for (int ks = 0; ks < 2; ++ks)
#pragma unroll
      for (int n = 0; n < NT; ++n) ub[ks][n] = *(const bf16x8*)(Ubt + (n * 16 + fr) * LU + ks * 32 + fq * 8);
#pragma unroll
    for (int ks = 0; ks < 2; ++ks)
#pragma unroll
      for (int n = 0; n < NT; ++n) Oacc[n] = mfma16(ub[ks][n], qkd[ks], Oacc[n]);
#pragma unroll
    for (int n = 0; n < NT; ++n)
      *(uint2*)(O + (size_t)(c * 64 + 16 * w + fr) * o_stride + n * 16 + fq * 4) = make_uint2(pk2(Oacc[n][0], Oacc[n][1]), pk2(Oacc[n][2], Oacc[n][3]));
#pragma unroll
    for (int m = 0; m < MT; ++m)
#pragma unroll
      for (int n = 0; n < NT; ++n) Sacc[m][n] = Sacc[m][n] * dc;
#pragma unroll
    for (int ks = 0; ks < 2; ++ks)
#pragma unroll
      for (int m = 0; m < MT; ++m)
#pragma unroll
        for (int n = 0; n < NT; ++n) Sacc[m][n] = mfma16(kdt[m][ks], ub[ks][n], Sacc[m][n]);
    lds_barrier();
#pragma unroll
    for (int m = 0; m < MT; ++m)
#pragma unroll
      for (int n = 0; n < NT; ++n)
        *(uint2*)(Sbt + (n * 16 + fr) * LS + w * (DK / 4) + m * 16 + fq * 4) = make_uint2(pk2(Sacc[m][n][0], Sacc[m][n][1]), pk2(Sacc[m][n][2], Sacc[m][n][3]));
    lds_barrier();
  }
#pragma unroll
  for (int m = 0; m < MT; ++m)
#pragma unroll
    for (int n = 0; n < NT; ++n)
#pragma unroll
      for (int jj = 0; jj < 4; ++jj) Sout[(size_t)(w * (DK / 4) + m * 16 + fq * 4 + jj) * s_stride + n * 16 + fr] = Sacc[m][n][jj];
  __builtin_amdgcn_s_setprio(0);
  __syncthreads();
}

__device__ __forceinline__ int queue_next(unsigned* ctr) {
  __shared__ int q_item;
  if (threadIdx.x == 0) q_item = (int)__hip_atomic_fetch_add(ctr, 1u, __ATOMIC_RELAXED, __HIP_MEMORY_SCOPE_AGENT);
  __syncthreads();
  const int it = q_item;
  __syncthreads();
  return it;
}
__device__ __forceinline__ void phase_prep_ab(const Params& p, char* lds) {
  const int NIT = 2048 + 4096;
  for (int it = blockIdx.x; it < NIT; it += gridDim.x) {
    if (it < 2048) gdn_prep_item(p, it, lds); else ssd_prep_item(p, it - 2048, lds);
  }
}
__device__ __forceinline__ void phase_scan_ab(const Params& p, char* lds) {
  constexpr int DVS = 64;
  const int N_G = 64 * (128 / DVS), N_S = 128 * (64 / DVS);
  bf16_t* oraw = (bf16_t*)(p.ws + W_ORAW);
  const float* dec = (const float*)(p.ws + W_DEC);
  const int half = gridDim.x >> 1;
  if ((int)blockIdx.x < half)
  for (int it = blockIdx.x; it < N_G + N_S; it += half) {
    if (it < N_G) {
      const int bh = it / (128 / DVS), sl = it % (128 / DVS), b = bh >> 3, h = bh & 7, e0 = sl * DVS;
      const char* blob0 = p.ws + W_GDNB + (size_t)(bh * 32) * GDN_BLOB;
      scan_item<128, DVS, true>(blob0, GDN_BLOB, dec + bh * 32, (const bf16_t*)(blob0 + 57344) + e0, 128, GDN_BLOB / 2,
                                oraw + (size_t)(b * SEQ) * 2048 + h * 128 + e0, 2048,
                                p.out + O_GDNP + (size_t)bh * 16384 + e0, 128, lds);
    } else {
      const int r = it - N_G; const int bh = r / (64 / DVS), sl = r % (64 / DVS), b = bh >> 4, h = bh & 15, e0 = sl * DVS;
      const char* blob0 = p.ws + W_SSDB + (size_t)(bh * 32) * SSD_BLOB;
      scan_item<128, DVS, false>(blob0, SSD_BLOB, dec + 2048 + bh * 32,
                                 (const bf16_t*)(p.ws + W_XBC) + (size_t)(b * SEQ) * CONV_CH + 3072 + h * 64 + e0, CONV_CH, (size_t)64 * CONV_CH,
                                 oraw + (size_t)(b * SEQ) * 2048 + 1024 + h * 64 + e0, 2048,
                                 p.out + O_SSMP + (size_t)bh * 8192 + e0, 64, lds);
    }
  }
  unsigned* qctr = (unsigned*)(p.ws + W_BAR) + 8;
  for (;;) {
    const int it = queue_next(qctr);
    if (it >= 1024 + 2048) break;
    if (it < 1024) gdn_sample_item(p, it, lds); else ssd_sample_item(p, it - 1024, lds);
  }
}
__device__ __forceinline__ void phase_prep_ret(const Params& p, char* lds) {
  for (int it = blockIdx.x; it < 1024; it += gridDim.x) ret_prep_item(p, it, lds);
}
__device__ __forceinline__ void phase_scan_ret(const Params& p, char* lds) {
  constexpr int DVS = 64;
  const int NS = 512 / DVS;
  bf16_t* oraw = (bf16_t*)(p.ws + W_ORAW);
  const float* dec = (const float*)(p.ws + W_DEC) + 6144;
  const int half = gridDim.x >> 1;
  if ((int)blockIdx.x < half)
  for (int it = blockIdx.x; it < 32 * NS; it += half) {
    const int bh = it / NS, sl = it % NS, b = bh >> 2, h = bh & 3, e0 = sl * DVS;
    const char* blob0 = p.ws + W_RETB + (size_t)(bh * 32) * RET_BLOB;
    scan_item<256, DVS, false>(blob0, RET_BLOB, dec + bh * 32,
                               (const bf16_t*)(p.ws + W_PROJ1) + (size_t)(b * SEQ) * RET_IN + 2048 + h * 512 + e0, RET_IN, (size_t)64 * RET_IN,
                               oraw + (size_t)(b * SEQ) * 2048 + h * 512 + e0, 2048,
                               p.out + O_RETP + (size_t)bh * 131072 + e0, 512, lds);
  }
  unsigned* qctr = (unsigned*)(p.ws + W_BAR) + 24;
  for (;;) {
    const int it = queue_next(qctr);
    if (it >= 2048) break;
    ret_sample_item(p, it, lds);
  }
}

__device__ __forceinline__ void phase_post_ab(const Params& p) {
  const int lane = tidx() & 63, wave = tidx() >> 6;
  const bf16_t* oraw = (const bf16_t*)(p.ws + W_ORAW); const bf16_t* gz = (const bf16_t*)(p.ws + W_GZ);
  const bf16_t* xbc = (const bf16_t*)(p.ws + W_XBC); bf16_t* a2 = (bf16_t*)(p.ws + W_A2);
  for (int t = blockIdx.x * 4 + wave; t < NTOK; t += gridDim.x * 4) {
#pragma unroll
    for (int j = 0; j < 2; ++j) {
      const int c = j * 512 + lane * 8;
      float o[8], gt[8], gn[8];
      unpack8(ldnt_u4(oraw + (size_t)t * 2048 + c), o); unpack8(ldnt_u4(gz + (size_t)t * GZ_W + c), gt);
      load8f(p.gdn_norm_g + (c & 127), gn);
      float ss = 0.f;
#pragma unroll
      for (int i = 0; i < 8; ++i) ss += o[i] * o[i];
      ss = grp16_sum(ss);
      const float rstd = rsqrtf(ss * (1.f / 128.f) + 1e-6f);
#pragma unroll
      for (int i = 0; i < 8; ++i) o[i] = o[i] * rstd * gn[i] * siluf_(gt[i]);
      *(uint4*)(a2 + (size_t)t * 2048 + c) = pack8(o);
    }
    float ob[16]; float ss = 0.f;
#pragma unroll
    for (int j = 0; j < 2; ++j) {
      const int c = j * 512 + lane * 8;
      float o[8], xs[8], z[8];
      unpack8(ldnt_u4(oraw + (size_t)t * 2048 + 1024 + c), o); unpack8(ldnt_u4(xbc + (size_t)t * CONV_CH + 3072 + c), xs);
      unpack8(ldnt_u4(gz + (size_t)t * GZ_W + 1024 + c), z);
      const float dd = p.ssm_d[c >> 6];
#pragma unroll
      for (int i = 0; i < 8; ++i) { float v = (o[i] + dd * xs[i]) * siluf_(z[i]); ob[j * 8 + i] = v; ss += v * v; }
    }
    ss = wave_sum(ss);
    const float rstd = rsqrtf(ss * (1.f / 1024.f) + 1e-6f);
#pragma unroll
    for (int j = 0; j < 2; ++j) {
      const int c = j * 512 + lane * 8;
      float gn[8], o[8]; load8f(p.ssm_norm_g + c, gn);
#pragma unroll
      for (int i = 0; i < 8; ++i) o[i] = ob[j * 8 + i] * rstd * gn[i];
      *(uint4*)(a2 + (size_t)t * 2048 + 1024 + c) = pack8(o);
    }
  }
}
__device__ __forceinline__ void phase_post_ret(const Params& p) {
  const int lane = tidx() & 63, wave = tidx() >> 6;
  const bf16_t* oraw = (const bf16_t*)(p.ws + W_ORAW); const bf16_t* pj = (const bf16_t*)(p.ws + W_PROJ1); bf16_t* a2 = (bf16_t*)(p.ws + W_A2);
  for (int t = blockIdx.x * 4 + wave; t < NTOK; t += gridDim.x * 4) {
#pragma unroll
    for (int h = 0; h < 4; ++h) {
      const int c = h * 512 + lane * 8;
      float o[8], gt[8], gn[8];
      unpack8(ldnt_u4(oraw + (size_t)t * 2048 + c), o); unpack8(ldnt_u4(pj + (size_t)t * RET_IN + 4096 + c), gt);
      load8f(p.ret_norm_g + c, gn);
      float s = 0.f;
#pragma unroll
      for (int i = 0; i < 8; ++i) s += o[i];
      const float mu = wave_sum(s) * (1.f / 512.f);
      float vs = 0.f;
#pragma unroll
      for (int i = 0; i < 8; ++i) { o[i] -= mu; vs += o[i] * o[i]; }
      const float rstd = rsqrtf(wave_sum(vs) * (1.f / 512.f) + 1e-6f);
#pragma unroll
      for (int i = 0; i < 8; ++i) o[i] = o[i] * rstd * gn[i] * siluf_(gt[i]);
      *(uint4*)(a2 + (size_t)t * 2048 + c) = pack8(o);
    }
  }
}

__device__ __forceinline__ void phase_topk(const Params& p, int layer, char* lds) {
  float* sc = (float*)lds;
  float* tkv = sc + 128 * 129;
  unsigned char* tki = (unsigned char*)(tkv + 128 * 16);
  const int tid = tidx(), lane = tid & 63, w = tid >> 6, fr = lane & 15, fq = lane >> 4;
  const bf16_t* qb = (const bf16_t*)(p.ws + W_ORAW);
  const bf16_t* keys = (const bf16_t*)(p.ws + W_KEYS) + (size_t)layer * 2 * 128 * 128;
  int* oidx = (int*)(p.ws + W_TKI); float* ogate = (float*)(p.ws + W_TKG);
  for (int item = blockIdx.x; item < 258 * 8; item += gridDim.x) {
    const int tt = item >> 3, h = item & 7, t0 = tt * 64;
#pragma unroll 1
    for (int pp = 0; pp < 2; ++pp) {
      f32x4 acc[8];
#pragma unroll
      for (int n = 0; n < 8; ++n) acc[n] = (f32x4){0.f, 0.f, 0.f, 0.f};
#pragma unroll
      for (int ks = 0; ks < 4; ++ks) {
        bf16x8 bq = ld16(qb + (size_t)(t0 + 16 * w + fr) * 2048 + h * 256 + pp * 128 + ks * 32 + fq * 8);
#pragma unroll
        for (int n = 0; n < 8; ++n) { bf16x8 a = ld16(keys + (size_t)(pp * 128 + n * 16 + fr) * 128 + ks * 32 + fq * 8); acc[n] = mfma16(a, bq, acc[n]); }
      }
#pragma unroll
      for (int n = 0; n < 8; ++n)
#pragma unroll
        for (int jj = 0; jj < 4; ++jj) sc[((16 * w + fr) * 2 + pp) * 129 + n * 16 + fq * 4 + jj] = acc[n][jj];
    }
    __syncthreads();
    {
      const int row = tid >> 1, hf = tid & 1; float* r = sc + row * 129 + hf;
      float gmax[8];
#pragma unroll
      for (int g = 0; g < 8; ++g) {
        float m = r[2 * (8 * g)];
#pragma unroll
        for (int i = 1; i < 8; ++i) m = fmaxf(m, r[2 * (8 * g + i)]);
        gmax[g] = m;
      }
#pragma unroll 1
      for (int it = 0; it < 16; ++it) {
        float best = gmax[0]; int bg = 0;
#pragma unroll
        for (int g = 1; g < 8; ++g) if (gmax[g] > best) { best = gmax[g]; bg = g; }
        int bj = 8 * bg + 7;
#pragma unroll
        for (int i = 6; i >= 0; --i) if (r[2 * (8 * bg + i)] == best) bj = 8 * bg + i;
        int bi = 2 * bj + hf;
        const float ov = __shfl_xor(best, 1); const int oi = __shfl_xor(bi, 1);
        const bool take = (ov > best) || (ov == best && oi < bi);
        if (!take) {
          r[2 * bj] = -INFINITY;
          float m = r[2 * (8 * bg)];
#pragma unroll
          for (int i = 1; i < 8; ++i) m = fmaxf(m, r[2 * (8 * bg + i)]);
#pragma unroll
          for (int g = 0; g < 8; ++g) if (g == bg) gmax[g] = m;
        }
        if (hf == 0) { tkv[row * 16 + it] = take ? ov : best; tki[row * 16 + it] = (unsigned char)(take ? oi : bi); }
      }
    }
    __syncthreads();
    {
      const int tok = tid >> 2, qd = tid & 3;
      const float* v0 = tkv + (tok * 2) * 16; const float* v1 = v0 + 16;
      float a0[4]; int ptr[4];
#pragma unroll
      for (int i = 0; i < 4; ++i) { a0[i] = v0[qd * 4 + i]; ptr[i] = 0; }
      float cv[16]; int ci[16];
#pragma unroll
      for (int it = 0; it < 16; ++it) {
        float best = -INFINITY; int bidx = 1 << 30;
#pragma unroll
        for (int i = 0; i < 4; ++i) {
          const float cnd = (ptr[i] < 16) ? a0[i] + v1[ptr[i] & 15] : -INFINITY; const int fi = (qd * 4 + i) * 16 + ptr[i];
          if (cnd > best || (cnd == best && fi < bidx)) { best = cnd; bidx = fi; }
        }
#pragma unroll
        for (int off = 1; off < 4; off <<= 1) {
          const float ov = __shfl_xor(best, off); const int oi = __shfl_xor(bidx, off);
          if (ov > best || (ov == best && oi < bidx)) { best = ov; bidx = oi; }
        }
        const int wa = bidx >> 4;
#pragma unroll
        for (int i = 0; i < 4; ++i) if (wa == qd * 4 + i) ptr[i]++;
        cv[it] = best; ci[it] = bidx;
      }
      const float m = cv[0];
      float ev[16]; float es = 0.f;
#pragma unroll
      for (int it = 0; it < 16; ++it) { ev[it] = __expf(cv[it] - m); es += ev[it]; }
      const float inv = 1.f / es;
      const unsigned char* i0 = tki + (tok * 2) * 16; const unsigned char* i1 = i0 + 16;
      const size_t ob = ((size_t)(t0 + tok) * 8 + h) * 16;
#pragma unroll
      for (int it = 0; it < 16; ++it) {
        if ((it >> 2) == qd) { oidx[ob + it] = (int)i0[ci[it] >> 4] * 128 + (int)i1[ci[it] & 15]; ogate[ob + it] = ev[it] * inv; }
      }
    }
    __syncthreads();
  }
}

__device__ __forceinline__ void deq16(uint4 r, f32x2_t* f) {
  f[0] = __builtin_amdgcn_cvt_pk_f32_fp8((int)r.x, false); f[1] = __builtin_amdgcn_cvt_pk_f32_fp8((int)r.x, true);
  f[2] = __builtin_amdgcn_cvt_pk_f32_fp8((int)r.y, false); f[3] = __builtin_amdgcn_cvt_pk_f32_fp8((int)r.y, true);
  f[4] = __builtin_amdgcn_cvt_pk_f32_fp8((int)r.z, false); f[5] = __builtin_amdgcn_cvt_pk_f32_fp8((int)r.z, true);
  f[6] = __builtin_amdgcn_cvt_pk_f32_fp8((int)r.w, false); f[7] = __builtin_amdgcn_cvt_pk_f32_fp8((int)r.w, true);
}
__device__ __forceinline__ void gather_groups(const unsigned char* U, const unsigned char* V, const bf16_t* hm, const int* tki, const float* tkg,
                                              int t, int gb, int ge, int lane, f32x2_t* y) {
  f32x2_t xv[8];
  {
    float f[16];
    unpack8(*(const uint4*)(hm + (size_t)t * D + lane * 16), f); unpack8(*(const uint4*)(hm + (size_t)t * D + lane * 16 + 8), f + 8);
#pragma unroll
    for (int i = 0; i < 8; ++i) xv[i] = (f32x2_t){f[2 * i], f[2 * i + 1]};
  }
  const int id0 = tki[(size_t)t * 128 + lane], id1 = tki[(size_t)t * 128 + 64 + lane];
  const float g0 = tkg[(size_t)t * 128 + lane], g1 = tkg[(size_t)t * 128 + 64 + lane];
  uint4 ra[8], rb[8]; int rida[8], ridb[8]; float gta[8], gtb[8];
#define G_LOADU(R, RID, GT, g) _Pragma("unroll") for (int e = 0; e < 8; ++e) { \
    const int k = ((g) * 8 + e) & 63; \
    RID[e] = __builtin_amdgcn_readlane((g) < 8 ? id0 : id1, k); \
    R[e] = *(const uint4*)(U + (size_t)RID[e] * 1024 + lane * 16); }
#define G_DOTS(R, RID, GT, g) { float dl = 0.f; \
    _Pragma("unroll") for (int e = 0; e < 8; ++e) { \
      f32x2_t f[8]; deq16(R[e], f); f32x2_t d2 = f[0] * xv[0]; \
      _Pragma("unroll") for (int i = 1; i < 8; ++i) d2 += f[i] * xv[i]; \
      const float d = wave_sum_fast(d2[0] + d2[1]); \
      dl = (lane == (((g) * 8 + e) & 63)) ? d : dl; \
      R[e] = *(const uint4*)(V + (size_t)RID[e] * 1024 + lane * 16); } \
    const float al = geluf_(dl * (1.f / U_SCALE)) * ((g) < 8 ? g0 : g1) * (1.f / V_SCALE);     \
    _Pragma("unroll") for (int e = 0; e < 8; ++e) GT[e] = __int_as_float(__builtin_amdgcn_readlane(__float_as_int(al), ((g) * 8 + e) & 63)); }
#define G_ACC(R, GT) _Pragma("unroll") for (int e = 0; e < 8; ++e) { \
    f32x2_t f[8]; deq16(R[e], f); const f32x2_t a2 = (f32x2_t){GT[e], GT[e]}; \
    _Pragma("unroll") for (int i = 0; i < 8; ++i) y[i] += a2 * f[i]; }
  G_LOADU(ra, rida, gta, gb)
#pragma unroll 1
  for (int g = gb; g < ge; g += 2) {
    G_DOTS(ra, rida, gta, g)
    G_LOADU(rb, ridb, gtb, g + 1)
    __builtin_amdgcn_sched_barrier(0);
    G_ACC(ra, gta)
    G_DOTS(rb, ridb, gtb, g + 1)
    if (g + 2 < ge) { G_LOADU(ra, rida, gta, g + 2) }
    __builtin_amdgcn_sched_barrier(0);
    G_ACC(rb, gtb)
  }
#undef G_LOADU
#undef G_DOTS
#undef G_ACC
}
__device__ __forceinline__ void gather_epilogue(const Params& p, int layer, int t, const f32x2_t* y, int lane) {
  bf16_t* hm = (bf16_t*)(p.ws + W_HM);
  float* xws = (float*)(p.ws + W_X);
  const float* mod = (const float*)(p.ws + W_MOD);
  const int c0 = lane * 16;
  const float* mr = mod + (size_t)seq_row(t) * 12288 + layer * 6144;
  float xr[16]; float ss = 0.f;
  {
    float xo[16], g2[16];
    load8f(xws + (size_t)t * D + c0, xo); load8f(xws + (size_t)t * D + c0 + 8, xo + 8);
    load8f(mr + 5 * 1024 + c0, g2); load8f(mr + 5 * 1024 + c0 + 8, g2 + 8);
#pragma unroll
    for (int i = 0; i < 16; ++i) { const float v = xo[i] + g2[i] * y[i >> 1][i & 1]; xr[i] = v; ss += v * v; }
  }
  ss = wave_sum(ss);
  const float rstd = rsqrtf(ss * (1.f / D) + 1e-6f);
  if (layer == 0) {
    store8f(xws + (size_t)t * D + c0, xr); store8f(xws + (size_t)t * D + c0 + 8, xr + 8);
    const float* m1 = mod + (size_t)seq_row(t) * 12288 + 6144;
    float gg[16], s1[16], s2[16], o[16];
    load8f(p.norm1_g + D + c0, gg); load8f(p.norm1_g + D + c0 + 8, gg + 8);
    load8f(m1 + 1024 + c0, s1); load8f(m1 + 1024 + c0 + 8, s1 + 8);
    load8f(m1 + c0, s2); load8f(m1 + c0 + 8, s2 + 8);
#pragma unroll
    for (int i = 0; i < 16; ++i) o[i] = xr[i] * rstd * gg[i] * (1.f + s1[i]) + s2[i];
    *(uint4*)(hm + (size_t)t * D + c0) = pack8(o); *(uint4*)(hm + (size_t)t * D + c0 + 8) = pack8(o + 8);
  } else {
    float gg[16], o[16];
    load8f(p.final_g + c0, gg); load8f(p.final_g + c0 + 8, gg + 8);
#pragma unroll
    for (int i = 0; i < 16; ++i) o[i] = xr[i] * rstd * gg[i];
    { float* yo = p.out + O_Y + (size_t)t * D + c0;
      stnt4(yo, make_float4(o[0], o[1], o[2], o[3])); stnt4(yo + 4, make_float4(o[4], o[5], o[6], o[7]));
      stnt4(yo + 8, make_float4(o[8], o[9], o[10], o[11])); stnt4(yo + 12, make_float4(o[12], o[13], o[14], o[15])); }
  }
}
__device__ __forceinline__ void phase_gather(const Params& p, int layer, char* lds) {
  const int lane = tidx() & 63, wave = tidx() >> 6;
  const unsigned char* U = (const unsigned char*)(p.ws + W_U) + (size_t)layer * 16384 * 1024;
  const unsigned char* V = (const unsigned char*)(p.ws + W_V) + (size_t)layer * 16384 * 1024;
  const bf16_t* hm = (const bf16_t*)(p.ws + W_HM);
  const int* tki = (const int*)(p.ws + W_TKI); const float* tkg = (const float*)(p.ws + W_TKG);
  for (int t = blockIdx.x * 4 + wave; t < NPT; t += gridDim.x * 4) {
    f32x2_t y[8];
#pragma unroll
    for (int i = 0; i < 8; ++i) y[i] = (f32x2_t){0.f, 0.f};
    gather_groups(U, V, hm, tki, tkg, t, 0, 16, lane, y);
    gather_epilogue(p, layer, t, y, lane);
  }
  float* part = (float*)lds;
  for (int tt = blockIdx.x; tt < NTOK - NPT; tt += gridDim.x) {
    const int t = NPT + tt;
    f32x2_t y[8];
#pragma unroll
    for (int i = 0; i < 8; ++i) y[i] = (f32x2_t){0.f, 0.f};
    gather_groups(U, V, hm, tki, tkg, t, wave * 4, wave * 4 + 4, lane, y);
#pragma unroll
    for (int i = 0; i < 8; ++i) *(f32x2_t*)(part + wave * 1024 + lane * 16 + 2 * i) = y[i];
    __syncthreads();
    if (wave == 0) {
#pragma unroll
      for (int i = 0; i < 8; ++i) {
        f32x2_t a = *(const f32x2_t*)(part + lane * 16 + 2 * i);
        a += *(const f32x2_t*)(part + 1024 + lane * 16 + 2 * i); a += *(const f32x2_t*)(part + 2048 + lane * 16 + 2 * i); a += *(const f32x2_t*)(part + 3072 + lane * 16 + 2 * i);
        y[i] = a;
      }
      gather_epilogue(p, layer, t, y, lane);
    }
    __syncthreads();
  }
}

#define XB_TMO      128
#define XB_XCNT(j)  (256  + 64 * (j))
#define XB_XSUB(j)  (1280 + 64 * (j))
#define XB_XGEN(j)  (2304 + 64 * (j))
#define XB_TOP      3328
#define XB_TOPGEN   3392
#define XCD_BAR_WORDS 3456
#define XB_SPIN_CAP (1u << 22)
#define LAS __attribute__((address_space(3)))
__device__ __forceinline__ unsigned xb_ld(unsigned* p)              { return __hip_atomic_load(p, __ATOMIC_RELAXED, __HIP_MEMORY_SCOPE_AGENT); }
__device__ __forceinline__ unsigned xb_add(unsigned* p, unsigned v) { return __hip_atomic_fetch_add(p, v, __ATOMIC_RELAXED, __HIP_MEMORY_SCOPE_AGENT); }
__device__ __forceinline__ unsigned xb_xcc_id() { return (unsigned)__builtin_amdgcn_s_getreg((3 << 11) | 20) & 0xFu; }
#define XB_SPIN(cond, bar) do { unsigned _sp = 0; while (cond) { __builtin_amdgcn_s_sleep(1); \
    if ((++_sp & 255u) == 0u) { if (xb_ld(&(bar)[XB_TMO])) break; if (_sp > XB_SPIN_CAP) { atomicAdd(&(bar)[XB_TMO], 1u); break; } } } } while (0)
struct XcdBarrier { unsigned* bar; unsigned x; volatile unsigned* st; };
__device__ __forceinline__ XcdBarrier xcd_barrier_post(unsigned* bar, volatile unsigned* st) {
  XcdBarrier b; b.bar = bar; b.x = xb_xcc_id(); b.st = st;
  if (threadIdx.x == 0) (void)xb_add(&bar[XB_XCNT(b.x)], 1u);
  return b;
}
__device__ __forceinline__ void xcd_barrier_complete(unsigned* bar, unsigned x, unsigned& nloc, unsigned& nx) {
  const unsigned G = gridDim.x;
  unsigned sum, cnt, mine, sp = 0u;
  for (;;) {
    sum = 0u; cnt = 0u; mine = 0u;
#pragma unroll
    for (unsigned j = 0; j < 16; ++j) { const unsigned c = xb_ld(&bar[XB_XCNT(j)]); sum += c; cnt += (c > 0u) ? 1u : 0u; mine = (j == x) ? c : mine; }
    if (sum == G) break;
    __builtin_amdgcn_s_sleep(1);
    if ((++sp & 255u) == 0u) { if (xb_ld(&bar[XB_TMO])) break; if (sp > XB_SPIN_CAP) { atomicAdd(&bar[XB_TMO], 1u); break; } }
  }
  nloc = mine > 0u ? mine : 1u; nx = cnt > 0u ? cnt : 1u;
}
__device__ __forceinline__ void xcd_barrier(const XcdBarrier& b) {
  asm volatile("s_waitcnt vmcnt(0)" ::: "memory");
  __syncthreads();
  if (threadIdx.x == 0) {
    unsigned* bar = b.bar;
    __builtin_amdgcn_s_waitcnt(0);
    unsigned nloc = b.st[0], nx = b.st[1];
    if (nloc == 0u) { xcd_barrier_complete(bar, b.x, nloc, nx); b.st[0] = nloc; b.st[1] = nx; }
    const unsigned old = xb_add(&bar[XB_XSUB(b.x)], 1u);
    const unsigned gen = old / nloc;
    if (old + 1u == (gen + 1u) * nloc) {
      __builtin_amdgcn_fence(__ATOMIC_RELEASE, "agent");
      asm volatile("s_waitcnt vmcnt(0)" ::: "memory");
      const unsigned og = xb_add(&bar[XB_TOP], 1u);
      const unsigned tg = og / nx;
      if (og + 1u == (tg + 1u) * nx) xb_add(&bar[XB_TOPGEN], 1u);
      else XB_SPIN(xb_ld(&bar[XB_TOPGEN]) == tg, bar);
      __builtin_amdgcn_fence(__ATOMIC_ACQUIRE, "agent");
      xb_add(&bar[XB_XGEN(b.x)], 1u);
      asm volatile("s_waitcnt vmcnt(0)" ::: "memory");
    } else {
      XB_SPIN(xb_ld(&bar[XB_XGEN(b.x)]) == gen, bar);
      __builtin_amdgcn_fence(__ATOMIC_ACQUIRE, "agent");
      asm volatile("s_waitcnt vmcnt(0)" ::: "memory");
    }
  }
  __syncthreads();
}

__device__ __forceinline__ void gsync(cg::grid_group& grid) {
  __threadfence();
  grid.sync();
  __builtin_amdgcn_fence(__ATOMIC_ACQUIRE, "agent");
  asm volatile("s_waitcnt vmcnt(0)" ::: "memory");
}
__device__ __forceinline__ void zfill(float* o, size_t a, size_t b) {
  for (size_t i = a + (size_t)blockIdx.x * NTHR + tidx(); i < b; i += (size_t)gridDim.x * NTHR) o[i] = 0.f;
}
__global__ void __launch_bounds__(NTHR, 2) mega(Params p) {
  __shared__ __attribute__((aligned(16))) char lds[LDS_BYTES];
  __shared__ uint4 xb_words;
  if (threadIdx.x == 0) xb_words = make_uint4(0u, 0u, 0u, 0u);
  __syncthreads();
  const XcdBarrier xb = xcd_barrier_post((unsigned*)(p.ws + W_BAR), (volatile unsigned*)&xb_words);
  char* ws = p.ws;
  float* mod = (float*)(ws + W_MOD);
  bf16_t* hm = (bf16_t*)(ws + W_HM);
  float* xws = (float*)(ws + W_X);

#pragma unroll 1
  for (int rep = 0; rep < REP_P0; ++rep)
    phase_prep(p, lds);
  xcd_barrier(xb);
#if STOP_AFTER == 1
  zfill(p.out, O_Y, O_CONVP); zfill(p.out, O_GDNS, O_RETS); zfill(p.out, O_GDNP, O_RETP); zfill(p.out, O_RETS, O_RETS + 67108864); zfill(p.out, O_RETP, O_CONVS);
  return;
#endif
#pragma unroll 1
  for (int rep = 0; rep < REP_SYNC; ++rep) xcd_barrier(xb);
  gemm_phase((const bf16_t*)(ws + W_SILUC), (const bf16_t*)(ws + W_ADA_T), NSEQ, 12288, 1024, lds, EpiMod{mod, p.ada_b});
  xcd_barrier(xb);
#if STOP_AFTER == 2
  zfill(p.out, O_Y, O_CONVP); zfill(p.out, O_GDNS, O_RETS); zfill(p.out, O_GDNP, O_RETP); zfill(p.out, O_RETS, O_RETS + 67108864); zfill(p.out, O_RETP, O_CONVS);
  return;
#endif
#pragma unroll 1
  for (int rep = 0; rep < REP_ELT; ++rep)
    phase_adaln(p, 0, 0, true);
  xcd_barrier(xb);
#if STOP_AFTER == 3
  zfill(p.out, O_Y, O_CONVP); zfill(p.out, O_GDNS, O_RETS); zfill(p.out, O_GDNP, O_RETP); zfill(p.out, O_RETS, O_RETS + 67108864); zfill(p.out, O_RETP, O_CONVS);
  return;
#endif
#pragma unroll 1
  for (int rep = 0; rep < REP_GEMM; ++rep)
  gemm_phase(hm, (const bf16_t*)(ws + W_IN0_T), NTOK, AB_IN, 1024, lds, EpiProj0{(bf16_t*)(ws + W_PRE), (bf16_t*)(ws + W_GZ)});
  xcd_barrier(xb);
#if STOP_AFTER == 4
  zfill(p.out, O_Y, O_CONVP); zfill(p.out, O_GDNS, O_RETS); zfill(p.out, O_GDNP, O_RETP); zfill(p.out, O_RETS, O_RETS + 67108864); zfill(p.out, O_RETP, O_CONVS);
  return;
#endif
#pragma unroll 1
  for (int rep = 0; rep < REP_ELT; ++rep)
    phase_conv(p);
  xcd_barrier(xb);
#if STOP_AFTER == 5
  zfill(p.out, O_Y, O_CONVP); zfill(p.out, O_GDNS, O_RETS); zfill(p.out, O_GDNP, O_RETP); zfill(p.out, O_RETS, O_RETS + 67108864); zfill(p.out, O_RETP, O_CONVS);
  return;
#endif
#pragma unroll 1
  for (int rep = 0; rep < REP_PREP; ++rep)
    phase_prep_ab(p, lds);
  xcd_barrier(xb);
#if STOP_AFTER == 6
  zfill(p.out, O_Y, O_CONVP); zfill(p.out, O_GDNP, O_RETP); zfill(p.out, O_RETS, O_RETS + 67108864); zfill(p.out, O_RETP, O_CONVS);
  return;
#endif
#pragma unroll 1
  for (int rep = 0; rep < REP_SCAN; ++rep)
    phase_scan_ab(p, lds);
  xcd_barrier(xb);
#if STOP_AFTER == 7
  zfill(p.out, O_Y, O_CONVP); zfill(p.out, O_RETS, O_RETS + 67108864); zfill(p.out, O_RETP, O_CONVS);
  return;
#endif
#pragma unroll 1
  for (int rep = 0; rep < REP_ELT; ++rep)
    phase_post_ab(p);
  xcd_barrier(xb);
#if STOP_AFTER == 8
  zfill(p.out, O_Y, O_CONVP); zfill(p.out, O_RETS, O_RETS + 67108864); zfill(p.out, O_RETP, O_CONVS);
  return;
#endif
#pragma unroll 1
  for (int rep = 0; rep < REP_GEMM; ++rep)
  gemm_phase((const bf16_t*)(ws + W_A2), (const bf16_t*)(ws + W_OUT0_T), NTOK, 1024, 2048, lds, EpiRes{p.x_prompt, p.x_sample, mod + 2048, xws, 1});
  xcd_barrier(xb);
#if STOP_AFTER == 9
  zfill(p.out, O_Y, O_CONVP); zfill(p.out, O_RETS, O_RETS + 67108864); zfill(p.out, O_RETP, O_CONVS);
  return;
#endif
#pragma unroll 1
  for (int rep = 0; rep < REP_ELT; ++rep)
    phase_adaln(p, 0, 1, false);
  xcd_barrier(xb);
#if STOP_AFTER == 10
  zfill(p.out, O_Y, O_CONVP); zfill(p.out, O_RETS, O_RETS + 67108864); zfill(p.out, O_RETP, O_CONVS);
  return;
#endif
#pragma unroll 1
  for (int rep = 0; rep < REP_GEMM; ++rep)
  gemm_phase(hm, (const bf16_t*)(ws + W_Q_T), NTOK, 2048, 1024, lds, EpiBf{(bf16_t*)(ws + W_ORAW), 2048});
  xcd_barrier(xb);
#if STOP_AFTER == 11
  zfill(p.out, O_Y, O_CONVP); zfill(p.out, O_RETS, O_RETS + 67108864); zfill(p.out, O_RETP, O_CONVS);
  return;
#endif
#pragma unroll 1
  for (int rep = 0; rep < REP_TOPK; ++rep) phase_topk(p, 0, lds);
  xcd_barrier(xb);
#if STOP_AFTER == 12
  zfill(p.out, O_Y, O_CONVP); zfill(p.out, O_RETS, O_RETS + 67108864); zfill(p.out, O_RETP, O_CONVS);
  return;
#endif
  phase_gather(p, 0, lds);
  xcd_barrier(xb);
#if STOP_AFTER == 13
  zfill(p.out, O_Y, O_CONVP); zfill(p.out, O_RETS, O_RETS + 67108864); zfill(p.out, O_RETP, O_CONVS);
  return;
#endif
#pragma unroll 1
  for (int rep = 0; rep < REP_GEMM; ++rep)
  gemm_phase(hm, (const bf16_t*)(ws + W_IN1_T), NTOK, RET_IN, 1024, lds, EpiBf{(bf16_t*)(ws + W_PROJ1), RET_IN});
  xcd_barrier(xb);
#if STOP_AFTER == 14
  zfill(p.out, O_Y, O_CONVP); zfill(p.out, O_RETS, O_RETS + 67108864); zfill(p.out, O_RETP, O_CONVS);
  return;
#endif
#pragma unroll 1
  for (int rep = 0; rep < REP_PREP; ++rep)
    phase_prep_ret(p, lds);
  xcd_barrier(xb);
#if STOP_AFTER == 15
  zfill(p.out, O_Y, O_CONVP); zfill(p.out, O_RETP, O_CONVS);
  return;
#endif
#pragma unroll 1
  for (int rep = 0; rep < REP_SCAN; ++rep)
    phase_scan_ret(p, lds);
  xcd_barrier(xb);
#if STOP_AFTER == 16
  zfill(p.out, O_Y, O_CONVP);
  return;
#endif
#pragma unroll 1
  for (int rep = 0; rep < REP_ELT; ++rep)
    phase_post_ret(p);
  xcd_barrier(xb);
#if STOP_AFTER == 17
  zfill(p.out, O_Y, O_CONVP);
  return;
#endif
  gemm_phase((const bf16_t*)(ws + W_A2), (const bf16_t*)(ws + W_OUT1_T), NTOK, 1024, 2048, lds, EpiRes{p.x_prompt, p.x_sample, mod + 6144 + 2048, xws, 0});
  xcd_barrier(xb);
#if STOP_AFTER == 18
  zfill(p.out, O_Y, O_CONVP);
  return;
#endif
#pragma unroll 1
  for (int rep = 0; rep < REP_ELT; ++rep)
    phase_adaln(p, 1, 1, false);
  xcd_barrier(xb);
#if STOP_AFTER == 19
  zfill(p.out, O_Y, O_CONVP);
  return;
#endif
#pragma unroll 1
  for (int rep = 0; rep < REP_GEMM; ++rep)
  gemm_phase(hm, (const bf16_t*)(ws + W_Q_T) + (size_t)2048 * 1024, NTOK, 2048, 1024, lds, EpiBf{(bf16_t*)(ws + W_ORAW), 2048});
  xcd_barrier(xb);
#if STOP_AFTER == 20
  zfill(p.out, O_Y, O_CONVP);
  return;
#endif
#pragma unroll 1
  for (int rep = 0; rep < REP_TOPK; ++rep) phase_topk(p, 1, lds);
  xcd_barrier(xb);
#if STOP_AFTER == 21
  zfill(p.out, O_Y, O_CONVP);
  return;
#endif
  phase_gather(p, 1, lds);
}

extern "C" void kernel_launch(void* const* d_in, const int* in_sizes, int n_in, void* d_out, int out_size, void* d_ws, size_t ws_size, hipStream_t stream) {
  static int grid_blocks = 0;
  if (grid_blocks == 0) {
    if (n_in != 31 || ws_size < W_END) { fprintf(stderr, "kernel_launch: need 31 inputs and %zu bytes of ws; got %d, %zu\n", (size_t)W_END, n_in, ws_size); grid_blocks = -1; return; }
    int dev = 0, cus = 0, per_cu = 0;
    (void)hipGetDevice(&dev);
    (void)hipDeviceGetAttribute(&cus, hipDeviceAttributeMultiprocessorCount, dev);
    (void)hipOccupancyMaxActiveBlocksPerMultiprocessor(&per_cu, mega, NTHR, 0);
    if (per_cu < 1) { fprintf(stderr, "kernel_launch: occupancy query returned %d\n", per_cu); grid_blocks = -1; return; }
    if (per_cu > 2) per_cu = 2;
    grid_blocks = cus * per_cu;
  }
  if (grid_blocks < 0) return;
  if (hipMemsetAsync((char*)d_ws + W_BAR, 0, XCD_BAR_WORDS * 4, stream) != hipSuccess) { fprintf(stderr, "kernel_launch: memset of barrier words failed\n"); return; }
  Params p{};
  const float** pf = (const float**)&p;
  for (int i = 0; i < 31; ++i) pf[i] = (const float*)d_in[i];
  p.out = (float*)d_out; p.ws = (char*)d_ws;
  void* args[] = {&p};
  hipError_t e = hipLaunchCooperativeKernel((void*)mega, dim3(grid_blocks), dim3(NTHR), args, 0, stream);
  if (e != hipSuccess) fprintf(stderr, "cooperative launch failed: %s (grid %d)\n", hipGetErrorString(e), grid_blocks);
}
```

```cpp
#include <hip/hip_runtime.h>
#include <hip/hip_cooperative_groups.h>
#include <cstdio>
#include <cstdint>
namespace cg = cooperative_groups;
#define STOP_AFTER 0
#define REP_GEMM 1
#define DBG_NCH 32
#ifndef REP_SCAN
#define REP_SCAN 1
#endif
#ifndef REP_PREP
#define REP_PREP 1
#endif
#ifndef REP_P0
#define REP_P0 1
#endif
#ifndef REP_SYNC
#define REP_SYNC 0
#endif
#ifndef REP_ELT
#define REP_ELT 1
#endif
#ifndef REP_GEMM
#define REP_GEMM 1
#endif
#ifndef REP_TOPK
#define REP_TOPK 1
#endif
#ifndef REP_GATHER
#define REP_GATHER 1
#endif

typedef unsigned short bf16_t;
typedef short bf16x8 __attribute__((ext_vector_type(8)));
typedef float f32x4 __attribute__((ext_vector_type(4)));
#define LDS_AS __attribute__((address_space(3)))

constexpr int D = 1024, NTOK = 16512, NPT = 16384, SEQ = 2048, NSEQ = 136;
constexpr int AB_IN = 6688, AB_IN_PAD = 6784, CONV_CH = 4608, GZ_W = 2080, RET_IN = 6144;
constexpr int NTHR = 256;
constexpr float U_SCALE = 256.f, V_SCALE = 16.f;
constexpr int LDS_BYTES = 77824;

constexpr size_t O_Y = 0, O_CONVP = 16908288, O_GDNP = 17018880, O_SSMP = 18067456, O_RETP = 19116032,
                 O_CONVS = 23310336, O_GDNS = 25079808, O_SSMS = 41857024, O_RETS = 58634240;

constexpr size_t al256(size_t x) { return (x + 255) & ~(size_t)255; }
constexpr size_t W_ADA_T = 0;
constexpr size_t W_IN0_T = W_ADA_T + al256((size_t)12288 * 1024 * 2);
constexpr size_t W_OUT0_T = W_IN0_T + al256((size_t)AB_IN_PAD * 1024 * 2);
constexpr size_t W_IN1_T = W_OUT0_T + al256((size_t)1024 * 2048 * 2);
constexpr size_t W_OUT1_T = W_IN1_T + al256((size_t)6144 * 1024 * 2);
constexpr size_t W_Q_T = W_OUT1_T + al256((size_t)1024 * 2048 * 2);
constexpr size_t W_KEYS = W_Q_T + al256((size_t)2 * 2048 * 1024 * 2);
constexpr size_t W_U = W_KEYS + al256((size_t)2 * 2 * 128 * 128 * 2);
constexpr size_t W_V = W_U + al256((size_t)2 * 16384 * 1024 * 2);
constexpr size_t W_SILUC = W_V + al256((size_t)2 * 16384 * 1024 * 2);
constexpr size_t W_MOD = W_SILUC + al256((size_t)256 * 1024 * 2);
constexpr size_t W_X = W_MOD + al256((size_t)NSEQ * 12288 * 4);
constexpr size_t W_HM = W_X + al256((size_t)NTOK * 1024 * 4);
constexpr size_t W_SCAL = W_HM + al256((size_t)NTOK * 1024 * 2);
constexpr size_t W_GZ = W_SCAL + al256((size_t)NTOK * 48 * 4);
constexpr size_t W_XBC = W_GZ + al256((size_t)NTOK * GZ_W * 2);
constexpr size_t W_ORAW = W_XBC + al256((size_t)NTOK * CONV_CH * 2);
constexpr size_t W_A2 = W_ORAW + al256((size_t)NTOK * 2048 * 2);
constexpr size_t W_TKI = W_A2 + al256((size_t)NTOK * 2048 * 2);
constexpr size_t W_TKG = W_TKI + al256((size_t)NTOK * 128 * 4);
constexpr size_t W_DEC = W_TKG + al256((size_t)NTOK * 128 * 4);
constexpr size_t W_BAR = W_DEC + al256((size_t)8192 * 4);
constexpr size_t W_BIG = W_BAR + al256((size_t)4096 * 4);
constexpr size_t GDN_BLOB = 73728, SSD_BLOB = 40960, RET_BLOB = 73728;
constexpr size_t W_PRE = W_BIG;
constexpr size_t W_GDNB = W_BIG;
constexpr size_t W_SSDB = W_GDNB + al256(2048 * GDN_BLOB);
constexpr size_t W_PROJ1 = W_BIG;
constexpr size_t W_RETB = W_PROJ1 + al256((size_t)NTOK * RET_IN * 2);
constexpr size_t W_END0 = W_SSDB + al256(4096 * SSD_BLOB);
constexpr size_t W_END1 = W_RETB + al256(1024 * RET_BLOB);
constexpr size_t W_END = W_END0 > W_END1 ? W_END0 : W_END1;

struct Params {
  const float *x_prompt, *x_sample, *c_prompt, *c_sample, *state_conv, *state_gdn, *state_ssm, *state_ret;
  const float *ada_w, *ada_b, *norm1_g, *norm2_g, *ab_w_in, *ab_conv_w, *ab_conv_b, *gdn_a_log, *gdn_dt_bias, *gdn_norm_g;
  const float *ssm_a_log, *ssm_dt_bias, *ssm_d, *ssm_norm_g, *ab_w_out, *ret_w_in, *ret_norm_g, *ret_w_out;
  const float *peer_w_q, *peer_keys, *peer_u, *peer_v, *final_g;
  float* out;
  char* ws;
};

__device__ __forceinline__ int tidx() { int t = threadIdx.x; asm volatile("" : "+v"(t)); return t; }
typedef __bf16 bf16x2_t __attribute__((ext_vector_type(2)));
typedef float f32x2_t __attribute__((ext_vector_type(2)));
__device__ __forceinline__ unsigned pk2(float lo, float hi) { f32x2_t v = {lo, hi}; bf16x2_t b = __builtin_convertvector(v, bf16x2_t); return __builtin_bit_cast(unsigned, b); }
__device__ __forceinline__ float bf_lo(unsigned u) { return __uint_as_float(u << 16); }
__device__ __forceinline__ float bf_hi(unsigned u) { return __uint_as_float(u & 0xffff0000u); }
__device__ __forceinline__ float bf2f(bf16_t h) { return __uint_as_float(((unsigned)h) << 16); }
__device__ __forceinline__ bf16_t f2bf(float f) { return (bf16_t)(pk2(f, 0.f) & 0xffffu); }
__device__ __forceinline__ void unpack8(uint4 v, float* f) {
  f[0] = bf_lo(v.x); f[1] = bf_hi(v.x); f[2] = bf_lo(v.y); f[3] = bf_hi(v.y);
  f[4] = bf_lo(v.z); f[5] = bf_hi(v.z); f[6] = bf_lo(v.w); f[7] = bf_hi(v.w);
}
__device__ __forceinline__ uint4 pack8(const float* f) { return make_uint4(pk2(f[0], f[1]), pk2(f[2], f[3]), pk2(f[4], f[5]), pk2(f[6], f[7])); }
__device__ __forceinline__ void load8f(const float* p, float* f) {
  float4 a = *(const float4*)p, b = *(const float4*)(p + 4);
  f[0] = a.x; f[1] = a.y; f[2] = a.z; f[3] = a.w; f[4] = b.x; f[5] = b.y; f[6] = b.z; f[7] = b.w;
}
__device__ __forceinline__ void store8f(float* p, const float* f) {
  *(float4*)p = make_float4(f[0], f[1], f[2], f[3]); *(float4*)(p + 4) = make_float4(f[4], f[5], f[6], f[7]);
}
__device__ __forceinline__ float wave_sum(float v) {
#pragma unroll
  for (int o = 1; o < 64; o <<= 1) v += __shfl_xor(v, o);
  return v;
}
__device__ __forceinline__ float dpp_add(float v, const int ctrl_sel) {
  int iv = __float_as_int(v), r;
  if (ctrl_sel == 0) r = __builtin_amdgcn_update_dpp(iv, iv, 0xB1, 0xF, 0xF, false);
  else if (ctrl_sel == 1) r = __builtin_amdgcn_update_dpp(iv, iv, 0x4E, 0xF, 0xF, false);
  else if (ctrl_sel == 2) r = __builtin_amdgcn_update_dpp(iv, iv, 0x141, 0xF, 0xF, false);
  else r = __builtin_amdgcn_update_dpp(iv, iv, 0x140, 0xF, 0xF, false);
  return v + __int_as_float(r);
}
__device__ __forceinline__ float wave_sum_fast(float v) {
  v = dpp_add(v, 0); v = dpp_add(v, 1); v = dpp_add(v, 2); v = dpp_add(v, 3);
  const int iv = __float_as_int(v);
  return (__int_as_float(__builtin_amdgcn_readlane(iv, 0)) + __int_as_float(__builtin_amdgcn_readlane(iv, 16))) +
         (__int_as_float(__builtin_amdgcn_readlane(iv, 32)) + __int_as_float(__builtin_amdgcn_readlane(iv, 48)));
}
__device__ __forceinline__ float grp16_sum(float v) {
#pragma unroll
  for (int o = 1; o < 16; o <<= 1) v += __shfl_xor(v, o);
  return v;
}
__device__ __forceinline__ float sigmoidf_(float x) { return 1.f / (1.f + __expf(-x)); }
__device__ __forceinline__ float siluf_(float x) { return x / (1.f + __expf(-x)); }
__device__ __forceinline__ float softplusf_(float x) { return fmaxf(x, 0.f) + log1pf(__expf(-fabsf(x))); }
__device__ __forceinline__ float geluf_(float x) { return 0.5f * x * (1.f + erff(x * 0.70710678118654752f)); }
__device__ __forceinline__ int seq_row(int t) { return t < NPT ? (t >> 11) : (8 + t - NPT); }
__device__ __forceinline__ const float* xin_row(const Params& p, int t) { return t < NPT ? p.x_prompt + (size_t)t * D : p.x_sample + (size_t)(t - NPT) * D; }
__device__ __forceinline__ bf16x8 ld16(const bf16_t* p) { return *(const bf16x8*)p; }
__device__ __forceinline__ float4 ldnt4(const float* p) { f32x4 v = __builtin_nontemporal_load((const f32x4*)p); return make_float4(v[0], v[1], v[2], v[3]); }
typedef unsigned u32x4_t __attribute__((ext_vector_type(4)));
__device__ __forceinline__ uint4 ldnt_u4(const void* p) { u32x4_t v = __builtin_nontemporal_load((const u32x4_t*)p); return make_uint4(v[0], v[1], v[2], v[3]); }
__device__ __forceinline__ void stnt4(float* p, float4 v) { f32x4 w = {v.x, v.y, v.z, v.w}; __builtin_nontemporal_store(w, (f32x4*)p); }
__device__ __forceinline__ f32x4 mfma16(bf16x8 a, bf16x8 b, f32x4 c) { return __builtin_amdgcn_mfma_f32_16x16x32_bf16(a, b, c, 0, 0, 0); }

__device__ __forceinline__ void transpose_item(const float* W, int K, int N, int Npad, bf16_t* WT, int item, float* tile) {
  const int nb = Npad / 64; const int kb = item / nb, nbi = item % nb; const int k0 = kb * 64, n0 = nbi * 64;
  const int tid = tidx();
#pragma unroll
  for (int i = 0; i < 16; ++i) {
    int kk = i * 4 + (tid >> 6), nn = tid & 63; int n = n0 + nn;
    tile[kk * 65 + nn] = (n < N) ? __builtin_nontemporal_load(W + (size_t)(k0 + kk) * N + n) : 0.f;
  }
  __syncthreads();
  {
    int n = tid >> 2, kc = (tid & 3) * 16;
    unsigned o[8];
#pragma unroll
    for (int j = 0; j < 8; ++j) o[j] = pk2(tile[(kc + 2 * j) * 65 + n], tile[(kc + 2 * j + 1) * 65 + n]);
    uint4* dst = (uint4*)(WT + (size_t)(n0 + n) * K + k0 + kc);
    dst[0] = make_uint4(o[0], o[1], o[2], o[3]); dst[1] = make_uint4(o[4], o[5], o[6], o[7]);
  }
  __syncthreads();
}
__device__ __forceinline__ void cvt_stream(const float* src, bf16_t* dst, size_t n8, size_t gtid, size_t gsz) {
  for (size_t i = gtid; i < n8; i += gsz) { float f[8]; load8f(src + i * 8, f); *(uint4*)(dst + i * 8) = pack8(f); }
}
__device__ __forceinline__ void cvt_stream_fp8(const float* src, unsigned char* dst, size_t n16, float scale, size_t gtid, size_t gsz) {
  const size_t n4 = n16 * 4;
  size_t i = gtid;
  for (; i + 3 * gsz < n4; i += 4 * gsz) {
    float4 f[4];
#pragma unroll
    for (int q = 0; q < 4; ++q) f[q] = ldnt4(src + (i + q * gsz) * 4);
#pragma unroll
    for (int q = 0; q < 4; ++q) {
      int v = __builtin_amdgcn_cvt_pk_fp8_f32(f[q].x * scale, f[q].y * scale, 0, false);
      v = __builtin_amdgcn_cvt_pk_fp8_f32(f[q].z * scale, f[q].w * scale, v, true);
      *(unsigned*)(dst + (i + q * gsz) * 4) = (unsigned)v;
    }
  }
  for (; i < n4; i += gsz) {
    float4 f = ldnt4(src + i * 4);
    int v = __builtin_amdgcn_cvt_pk_fp8_f32(f.x * scale, f.y * scale, 0, false);
    v = __builtin_amdgcn_cvt_pk_fp8_f32(f.z * scale, f.w * scale, v, true);
    *(unsigned*)(dst + i * 4) = (unsigned)v;
  }
}
__device__ __forceinline__ void phase_prep(const Params& p, char* lds) {
  float* tile = (float*)lds;
  char* ws = p.ws;
  const int I_ADA = 16 * 96, I_IN0 = 16 * 106, I_OUT = 32 * 16, I_IN1 = 16 * 96, I_Q = 16 * 32;
  const int NIT = 2 * I_ADA + I_IN0 + I_OUT + I_IN1 + I_OUT + 2 * I_Q;
  for (int it = blockIdx.x; it < NIT; it += gridDim.x) {
    int r = it;
    if (r < I_ADA) { transpose_item(p.ada_w, 1024, 6144, 6144, (bf16_t*)(ws + W_ADA_T), r, tile); continue; } r -= I_ADA;
    if (r < I_ADA) { transpose_item(p.ada_w + (size_t)1024 * 6144, 1024, 6144, 6144, (bf16_t*)(ws + W_ADA_T) + (size_t)6144 * 1024, r, tile); continue; } r -= I_ADA;
    if (r < I_IN0) { transpose_item(p.ab_w_in, 1024, AB_IN, AB_IN_PAD, (bf16_t*)(ws + W_IN0_T), r, tile); continue; } r -= I_IN0;
    if (r < I_OUT) { transpose_item(p.ab_w_out, 2048, 1024, 1024, (bf16_t*)(ws + W_OUT0_T), r, tile); continue; } r -= I_OUT;
    if (r < I_IN1) { transpose_item(p.ret_w_in, 1024, 6144, 6144, (bf16_t*)(ws + W_IN1_T), r, tile); continue; } r -= I_IN1;
    if (r < I_OUT) { transpose_item(p.ret_w_out, 2048, 1024, 1024, (bf16_t*)(ws + W_OUT1_T), r, tile); continue; } r -= I_OUT;
    if (r < I_Q) { transpose_item(p.peer_w_q, 1024, 2048, 2048, (bf16_t*)(ws + W_Q_T), r, tile); continue; } r -= I_Q;
    transpose_item(p.peer_w_q + (size_t)1024 * 2048, 1024, 2048, 2048, (bf16_t*)(ws + W_Q_T) + (size_t)2048 * 1024, r, tile);
  }
  const size_t gtid = (size_t)blockIdx.x * NTHR + tidx(), gsz = (size_t)gridDim.x * NTHR;
  cvt_stream_fp8(p.peer_u, (unsigned char*)(ws + W_U), (size_t)2 * 16384 * 1024 / 16, U_SCALE, gtid, gsz);
  cvt_stream_fp8(p.peer_v, (unsigned char*)(ws + W_V), (size_t)2 * 16384 * 1024 / 16, V_SCALE, gtid, gsz);
  cvt_stream(p.peer_keys, (bf16_t*)(ws + W_KEYS), (size_t)2 * 2 * 128 * 128 / 8, gtid, gsz);
  bf16_t* sc = (bf16_t*)(ws + W_SILUC);
  for (size_t i = gtid; i < (size_t)256 * 1024 / 8; i += gsz) {
    int r = (int)(i >> 7), c8 = (int)(i & 127) * 8;
    float f[8];
    if (r < NSEQ) {
      const float* src = (r < 8) ? p.c_prompt + (size_t)r * D + c8 : p.c_sample + (size_t)(r - 8) * D + c8;
      load8f(src, f);
#pragma unroll
      for (int j = 0; j < 8; ++j) f[j] = siluf_(f[j]);
    } else {
#pragma unroll
      for (int j = 0; j < 8; ++j) f[j] = 0.f;
    }
    *(uint4*)(sc + i * 8) = pack8(f);
  }
}

template <class Epi>
__device__ __forceinline__ void gemm_phase(const bf16_t* __restrict__ A, const bf16_t* __restrict__ Bt, int M, int N, int K, char* lds, Epi epi) {
  const int nM = (M + 127) / 128, nN = (N + 127) / 128;
  const int tid = tidx(), lane = tid & 63, wave = tid >> 6, wr = wave >> 1, wc = wave & 1, fr = lane & 15, fq = lane >> 4;
  char* As = lds; char* Bs = lds + 16384;
  const int sc = tid & 7, sr = tid >> 3;
  for (int tile = blockIdx.x; tile < nM * nN; tile += gridDim.x) {
    const int tm = tile / nN, tn = tile % nN; const int m0 = tm * 128, n0 = tn * 128;
    f32x4 acc[4][4];
#pragma unroll
    for (int m = 0; m < 4; ++m)
#pragma unroll
      for (int n = 0; n < 4; ++n) acc[m][n] = (f32x4){0.f, 0.f, 0.f, 0.f};
    const bf16_t* Ap = A + (size_t)(m0 + sr) * K + sc * 8;
    const bf16_t* Bp = Bt + (size_t)(n0 + sr) * K + sc * 8;
    const size_t K32 = (size_t)32 * K;
    uint4 ra0 = *(const uint4*)(Ap), ra1 = *(const uint4*)(Ap + K32), ra2 = *(const uint4*)(Ap + 2 * K32), ra3 = *(const uint4*)(Ap + 3 * K32);
    uint4 rb0 = *(const uint4*)(Bp), rb1 = *(const uint4*)(Bp + K32), rb2 = *(const uint4*)(Bp + 2 * K32), rb3 = *(const uint4*)(Bp + 3 * K32);
    const int off0 = sr * 128 + ((sc ^ (sr & 7)) << 4);
    for (int k0 = 0; k0 < K; k0 += 64) {
      __syncthreads();
      *(uint4*)(As + off0) = ra0; *(uint4*)(As + off0 + 4096) = ra1; *(uint4*)(As + off0 + 8192) = ra2; *(uint4*)(As + off0 + 12288) = ra3;
      *(uint4*)(Bs + off0) = rb0; *(uint4*)(Bs + off0 + 4096) = rb1; *(uint4*)(Bs + off0 + 8192) = rb2; *(uint4*)(Bs + off0 + 12288) = rb3;
      __syncthreads();
      {
        const int kn = (k0 + 64 < K) ? k0 + 64 : k0;
        ra0 = *(const uint4*)(Ap + kn); ra1 = *(const uint4*)(Ap + K32 + kn); ra2 = *(const uint4*)(Ap + 2 * K32 + kn); ra3 = *(const uint4*)(Ap + 3 * K32 + kn);
        rb0 = *(const uint4*)(Bp + kn); rb1 = *(const uint4*)(Bp + K32 + kn); rb2 = *(const uint4*)(Bp + 2 * K32 + kn); rb3 = *(const uint4*)(Bp + 3 * K32 + kn);
      }
#pragma unroll
      for (int kk = 0; kk < 2; ++kk) {
        bf16x8 af[4], bfv[4];
#pragma unroll
        for (int m = 0; m < 4; ++m) { int row = wr * 64 + m * 16 + fr; af[m] = *(const bf16x8*)(As + row * 128 + (((kk * 4 + fq) ^ (row & 7)) << 4)); }
#pragma unroll
        for (int n = 0; n < 4; ++n) { int row = wc * 64 + n * 16 + fr; bfv[n] = *(const bf16x8*)(Bs + row * 128 + (((kk * 4 + fq) ^ (row & 7)) << 4)); }
        __builtin_amdgcn_s_setprio(1);
#pragma unroll
        for (int m = 0; m < 4; ++m)
#pragma unroll
          for (int n = 0; n < 4; ++n) acc[m][n] = mfma16(bfv[n], af[m], acc[m][n]);
        __builtin_amdgcn_s_setprio(0);
      }
    }
#pragma unroll
    for (int m = 0; m < 4; ++m)
#pragma unroll
      for (int n = 0; n < 4; ++n) epi(m0 + wr * 64 + m * 16 + fr, n0 + wc * 64 + n * 16 + fq * 4, acc[m][n]);
  }
}

struct EpiMod { float* mod; const float* bias;
  __device__ __forceinline__ void operator()(int r, int c, f32x4 v) const {
    if (r < NSEQ) { float4 b = *(const float4*)(bias + c); *(float4*)(mod + (size_t)r * 12288 + c) = make_float4(v[0] + b.x, v[1] + b.y, v[2] + b.z, v[3] + b.w); } } };
struct EpiProj0 { bf16_t* pre; bf16_t* gz;
  __device__ __forceinline__ void operator()(int r, int c, f32x4 v) const {
    uint2 o = make_uint2(pk2(v[0], v[1]), pk2(v[2], v[3]));
    if (c < CONV_CH) *(uint2*)(pre + (size_t)r * CONV_CH + c) = o;
    else if (c < AB_IN) *(uint2*)(gz + (size_t)r * GZ_W + (c - CONV_CH)) = o; } };
struct EpiBf { bf16_t* dst; int ld;
  __device__ __forceinline__ void operator()(int r, int c, f32x4 v) const { *(uint2*)(dst + (size_t)r * ld + c) = make_uint2(pk2(v[0], v[1]), pk2(v[2], v[3])); } };
struct EpiRes { const float* xp; const float* xs; const float* gate;   float* xws; int from_input;
  __device__ __forceinline__ void operator()(int r, int c, f32x4 v) const {
    const float* xr = from_input ? (r < NPT ? xp + (size_t)r * D : xs + (size_t)(r - NPT) * D) : xws + (size_t)r * D;
    float4 x = *(const float4*)(xr + c); float4 g = *(const float4*)(gate + (size_t)seq_row(r) * 12288 + c);
    *(float4*)(xws + (size_t)r * D + c) = make_float4(x.x + g.x * v[0], x.y + g.y * v[1], x.z + g.z * v[2], x.w + g.w * v[3]); } };

__device__ __forceinline__ void adaln_write(const float* xv  , float ss, const float* g, const float* sc, const float* sh, bf16_t* orow, int lane) {
  const float rstd = rsqrtf(ss * (1.f / D) + 1e-6f);
#pragma unroll
  for (int j = 0; j < 2; ++j) {
    const int c = j * 512 + lane * 8;
    float gg[8], s1[8], s2[8], o[8];
    load8f(g + c, gg); load8f(sc + c, s1); load8f(sh + c, s2);
#pragma unroll
    for (int i = 0; i < 8; ++i) o[i] = xv[j * 8 + i] * rstd * gg[i] * (1.f + s1[i]) + s2[i];
    *(uint4*)(orow + c) = pack8(o);
  }
}
__device__ __forceinline__ void phase_adaln(const Params& p, int layer, int which, bool from_input) {
  const int lane = tidx() & 63, wave = tidx() >> 6;
  const float* mod = (const float*)(p.ws + W_MOD);
  bf16_t* hm = (bf16_t*)(p.ws + W_HM);
  const float* xws = (const float*)(p.ws + W_X);
  const float* g = (which == 0 ? p.norm1_g : p.norm2_g) + layer * D;
  for (int t = blockIdx.x * 4 + wave; t < NTOK; t += gridDim.x * 4) {
    const float* xr = from_input ? xin_row(p, t) : xws + (size_t)t * D;
    float xv[16]; load8f(xr + lane * 8, xv); load8f(xr + 512 + lane * 8, xv + 8);
    float ss = 0.f;
#pragma unroll
    for (int i = 0; i < 16; ++i) ss += xv[i] * xv[i];
    ss = wave_sum(ss);
    const float* mr = mod + (size_t)seq_row(t) * 12288 + layer * 6144 + which * 3072;
    adaln_write(xv, ss, g, mr + 1024, mr, hm + (size_t)t * D, lane);
  }
}

__device__ __forceinline__ void phase_conv(const Params& p) {
  const int lane = tidx() & 63, wave = tidx() >> 6;
  const bf16_t* pre = (const bf16_t*)(p.ws + W_PRE);
  const bf16_t* gz = (const bf16_t*)(p.ws + W_GZ);
  bf16_t* xbc = (bf16_t*)(p.ws + W_XBC);
  float* scal = (float*)(p.ws + W_SCAL);
  for (int t = blockIdx.x * 4 + wave; t < NTOK; t += gridDim.x * 4) {
    const bool smp = t >= NPT; const int b = smp ? t - NPT : (t >> 11); const int l = smp ? 0 : (t & 2047);
#pragma unroll 3
    for (int ch = 0; ch < 9; ++ch) {
      const int c = ch * 512 + lane * 8;
      float cur[8], p1[8], p2[8], p3[8];
      unpack8(*(const uint4*)(pre + (size_t)t * CONV_CH + c), cur);
      if (smp) {
        const float* st = p.state_conv + (size_t)b * 3 * CONV_CH + c;
        load8f(st + 2 * CONV_CH, p1); load8f(st + CONV_CH, p2); load8f(st, p3);
      } else {
        if (l >= 1) unpack8(*(const uint4*)(pre + (size_t)(t - 1) * CONV_CH + c), p1); else { for (int i = 0; i < 8; ++i) p1[i] = 0.f; }
        if (l >= 2) unpack8(*(const uint4*)(pre + (size_t)(t - 2) * CONV_CH + c), p2); else { for (int i = 0; i < 8; ++i) p2[i] = 0.f; }
        if (l >= 3) unpack8(*(const uint4*)(pre + (size_t)(t - 3) * CONV_CH + c), p3); else { for (int i = 0; i < 8; ++i) p3[i] = 0.f; }
      }
      float w0[8], w1[8], w2[8], w3[8], bb[8], y[8];
      load8f(p.ab_conv_w + c, w0); load8f(p.ab_conv_w + CONV_CH + c, w1); load8f(p.ab_conv_w + 2 * CONV_CH + c, w2); load8f(p.ab_conv_w + 3 * CONV_CH + c, w3);
      load8f(p.ab_conv_b + c, bb);
      float ss = 0.f;
#pragma unroll
      for (int i = 0; i < 8; ++i) { float v = bb[i] + w3[i] * cur[i] + w2[i] * p1[i] + w1[i] * p2[i] + w0[i] * p3[i]; v = siluf_(v); y[i] = v; ss += v * v; }
      if (ch < 4) {
        ss = grp16_sum(ss);
        float s = rsqrtf(ss + 1e-6f) * (ch < 2 ? 0.08838834764831845f : 1.f);
#pragma unroll
        for (int i = 0; i < 8; ++i) y[i] *= s;
      }
      *(uint4*)(xbc + (size_t)t * CONV_CH + c) = pack8(y);
      if (smp) {
        float* o = p.out + O_CONVS + (size_t)b * 3 * CONV_CH + c;
        store8f(o, p2); store8f(o + CONV_CH, p1); store8f(o + 2 * CONV_CH, cur);
      } else if (l >= SEQ - 3) {
        store8f(p.out + O_CONVP + ((size_t)b * 3 + (l - (SEQ - 3))) * CONV_CH + c, cur);
      }
    }
    if (lane < 32) {
      const bf16_t* gr = gz + (size_t)t * GZ_W + 2048;
      float v;
      if (lane < 8) { v = sigmoidf_(bf2f(gr[lane])); }
      else if (lane < 16) { int h = lane - 8; v = -__expf(p.gdn_a_log[h]) * softplusf_(bf2f(gr[8 + h]) + p.gdn_dt_bias[h]); }
      else { int h = lane - 16; v = softplusf_(bf2f(gr[16 + h]) + p.ssm_dt_bias[h]); }
      scal[(size_t)t * 48 + lane] = v;
      if (lane >= 16) { int h = lane - 16; scal[(size_t)t * 48 + 32 + h] = -v * __expf(p.ssm_a_log[h]); }
    }
  }
}

template <int DK>
__device__ __forceinline__ void qk_blobs(const bf16_t* qS, const bf16_t* kS, const float* gcS, const float* jsS, const float* betaS,
                                         bf16_t* Qg, bf16_t* KdT, bf16_t* QKd, float* Lout) {
  constexpr int LD = DK + 8, KS = DK / 32;
  const int tid = tidx(), lane = tid & 63, w = tid >> 6, fr = lane & 15, fq = lane >> 4;
  const int i = 16 * w + fr; const float gci = gcS[i];
#pragma unroll
  for (int nt = 0; nt < 4; ++nt) {
    f32x4 acc = (f32x4){0.f, 0.f, 0.f, 0.f}, acc2 = (f32x4){0.f, 0.f, 0.f, 0.f};
#pragma unroll
    for (int ks = 0; ks < KS; ++ks) {
      bf16x8 a = *(const bf16x8*)(kS + (nt * 16 + fr) * LD + ks * 32 + fq * 8);
      bf16x8 bq = *(const bf16x8*)(qS + i * LD + ks * 32 + fq * 8);
      acc = mfma16(a, bq, acc);
      if (Lout) { bf16x8 bk = *(const bf16x8*)(kS + i * LD + ks * 32 + fq * 8); acc2 = mfma16(a, bk, acc2); }
    }
    float o[4], lo[4];
#pragma unroll
    for (int jj = 0; jj < 4; ++jj) {
      const int j = nt * 16 + fq * 4 + jj;
      const float dcy = (j <= i) ? __expf(gci - gcS[j]) : 0.f;
      o[jj] = (j <= i) ? acc[jj] * dcy * jsS[j] : 0.f;
      lo[jj] = (j < i) ? acc2[jj] * dcy * betaS[i] : 0.f;
    }
    *(uint2*)(QKd + i * 64 + nt * 16 + fq * 4) = make_uint2(pk2(o[0], o[1]), pk2(o[2], o[3]));
    if (Lout) *(float4*)(Lout + i * 68 + nt * 16 + fq * 4) = make_float4(lo[0], lo[1], lo[2], lo[3]);
  }
  for (int idx = tid; idx < 64 * (DK / 8); idx += NTHR) {
    const int r = idx / (DK / 8), c8 = idx % (DK / 8);
    float f[8]; unpack8(*(const uint4*)(qS + r * LD + c8 * 8), f);
    const float s = __expf(gcS[r]);
#pragma unroll
    for (int q = 0; q < 8; ++q) f[q] *= s;
    *(uint4*)(Qg + r * DK + c8 * 8) = pack8(f);
  }
  const float glast = gcS[63];
  for (int idx = tid; idx < DK * 8; idx += NTHR) {
    const int d = idx >> 3, j0 = (idx & 7) * 8;
    float f[8];
#pragma unroll
    for (int q = 0; q < 8; ++q) f[q] = bf2f(kS[(j0 + q) * LD + d]) * jsS[j0 + q] * __expf(glast - gcS[j0 + q]);
    *(uint4*)(KdT + d * 64 + j0) = pack8(f);
  }
}

__device__ __forceinline__ float wave_incl_scan(float v, int lane) {
#pragma unroll
  for (int o = 1; o < 64; o <<= 1) { float u = __shfl_up(v, o); if (lane >= o) v += u; }
  return v;
}

__device__ __forceinline__ void gdn_prep_item(const Params& p, int it, char* lds) {
  constexpr int LD = 136;
  bf16_t* qS = (bf16_t*)lds; bf16_t* kS = qS + 64 * LD; float* L = (float*)(kS + 64 * LD);
  float* gcS = L + 64 * 68; float* jsS = gcS + 64; float* betaS = jsS + 64;
  const int tid = tidx(), lane = tid & 63;
  const int bh = it >> 5, c = it & 31, b = bh >> 3, h = bh & 7; const int t0 = b * SEQ + c * 64;
  const bf16_t* xbc = (const bf16_t*)(p.ws + W_XBC);
  const float* scal = (const float*)(p.ws + W_SCAL);
  char* blob = p.ws + W_GDNB + (size_t)it * GDN_BLOB;
  bf16_t* Qg = (bf16_t*)blob; bf16_t* KdT = Qg + 64 * 128; bf16_t* QKd = KdT + 128 * 64; bf16_t* Wn = QKd + 4096; bf16_t* U0 = Wn + 64 * 128;
  for (int idx = tid; idx < 64 * 16; idx += NTHR) {
    const int r = idx >> 4, c8 = (idx & 15) * 8;
    *(uint4*)(qS + r * LD + c8) = *(const uint4*)(xbc + (size_t)(t0 + r) * CONV_CH + h * 128 + c8);
    *(uint4*)(kS + r * LD + c8) = *(const uint4*)(xbc + (size_t)(t0 + r) * CONV_CH + 1024 + h * 128 + c8);
  }
  if (tid < 64) {
    float g = scal[(size_t)(t0 + tid) * 48 + 8 + h];
    float gc = wave_incl_scan(g, lane);
    gcS[tid] = gc; jsS[tid] = 1.f; betaS[tid] = scal[(size_t)(t0 + tid) * 48 + h];
    if (tid == 63) ((float*)(p.ws + W_DEC))[it] = __expf(gc);
  }
  __syncthreads();
  qk_blobs<128>(qS, kS, gcS, jsS, betaS, Qg, KdT, QKd, L);
  __syncthreads();
  float x[64];
  if (tid < 128) {
#pragma unroll
    for (int i = 0; i < 64; ++i) x[i] = bf2f(xbc[(size_t)(t0 + i) * CONV_CH + 2048 + h * 128 + tid]) * betaS[i];
  } else {
#pragma unroll
    for (int i = 0; i < 64; ++i) x[i] = bf2f(kS[i * LD + (tid - 128)]) * betaS[i] * __expf(gcS[i]);
  }
#pragma unroll
  for (int i = 1; i < 64; ++i) {
    float s0 = x[i], s1 = 0.f, s2 = 0.f, s3 = 0.f;
#pragma unroll
    for (int j4 = 0; j4 < (i + 3) / 4; ++j4) {
      float4 l = *(const float4*)(L + i * 68 + j4 * 4);
      if (j4 * 4 + 0 < i) s0 -= l.x * x[j4 * 4 + 0];
      if (j4 * 4 + 1 < i) s1 -= l.y * x[j4 * 4 + 1];
      if (j4 * 4 + 2 < i) s2 -= l.z * x[j4 * 4 + 2];
      if (j4 * 4 + 3 < i) s3 -= l.w * x[j4 * 4 + 3];
    }
    x[i] = (s0 + s1) + (s2 + s3);
  }
  if (tid < 128) {
#pragma unroll
    for (int i = 0; i < 64; ++i) U0[i * 128 + tid] = f2bf(x[i]);
  } else {
#pragma unroll
    for (int i = 0; i < 64; ++i) Wn[i * 128 + (tid - 128)] = f2bf(-x[i]);
  }
  __syncthreads();
#ifdef CHK_PREP
  { __threadfence(); unsigned xx = 0; const unsigned* wp = (const unsigned*)blob;
    for (int i = tid; i < (int)GDN_BLOB / 4; i += NTHR) xx ^= wp[i];
    p.out[O_GDNP + (size_t)it * 512 + tid] = (float)(xx & 0xFFFF); p.out[O_GDNP + (size_t)it * 512 + 256 + tid] = (float)(xx >> 16); }
#endif
}

__device__ __forceinline__ void ssd_prep_item(const Params& p, int it, char* lds) {
  constexpr int LD = 136;
  bf16_t* qS = (bf16_t*)lds; bf16_t* kS = qS + 64 * LD; float* gcS = (float*)(kS + 64 * LD); float* jsS = gcS + 64; float* betaS = jsS + 64;
  const int tid = tidx(), lane = tid & 63;
  const int bh = it >> 5, c = it & 31, b = bh >> 4, h = bh & 15, g = h >> 3; const int t0 = b * SEQ + c * 64;
  const bf16_t* xbc = (const bf16_t*)(p.ws + W_XBC);
  const float* scal = (const float*)(p.ws + W_SCAL);
  char* blob = p.ws + W_SSDB + (size_t)it * SSD_BLOB;
  bf16_t* Qg = (bf16_t*)blob; bf16_t* KdT = Qg + 64 * 128; bf16_t* QKd = KdT + 128 * 64;
  for (int idx = tid; idx < 64 * 16; idx += NTHR) {
    const int r = idx >> 4, c8 = (idx & 15) * 8;
    *(uint4*)(qS + r * LD + c8) = *(const uint4*)(xbc + (size_t)(t0 + r) * CONV_CH + 4352 + g * 128 + c8);
    *(uint4*)(kS + r * LD + c8) = *(const uint4*)(xbc + (size_t)(t0 + r) * CONV_CH + 4096 + g * 128 + c8);
  }
  if (tid < 64) {
    float la = scal[(size_t)(t0 + tid) * 48 + 32 + h];
    float gc = wave_incl_scan(la, lane);
    gcS[tid] = gc; jsS[tid] = scal[(size_t)(t0 + tid) * 48 + 16 + h]; betaS[tid] = 0.f;
    if (tid == 63) ((float*)(p.ws + W_DEC))[2048 + it] = __expf(gc);
  }
  __syncthreads();
  qk_blobs<128>(qS, kS, gcS, jsS, betaS, Qg, KdT, QKd, nullptr);
  __syncthreads();
}

__device__ __forceinline__ void rope_sincos(float pos, int dd, float& s, float& c) {
  const float inv = exp2f(-(float)dd * 0.10381025296523008f);
  const float ang = pos * inv;
  double r = (double)ang * 0.15915494309189535; r -= floor(r);
  const float fr = (float)r;
  s = __builtin_amdgcn_sinf(fr); c = __builtin_amdgcn_cosf(fr);
}

__device__ __forceinline__ void ret_prep_item(const Params& p, int it, char* lds) {
  constexpr int LD = 264;
  bf16_t* qS = (bf16_t*)lds; bf16_t* kS = qS + 64 * LD; float* gcS = (float*)(kS + 64 * LD); float* jsS = gcS + 64; float* betaS = jsS + 64;
  const int tid = tidx();
  const int bh = it >> 5, c = it & 31, b = bh >> 2, h = bh & 3; const int t0 = b * SEQ + c * 64;
  const bf16_t* pj = (const bf16_t*)(p.ws + W_PROJ1);
  char* blob = p.ws + W_RETB + (size_t)it * RET_BLOB;
  bf16_t* Qg = (bf16_t*)blob; bf16_t* KdT = Qg + 64 * 256; bf16_t* QKd = KdT + 256 * 64;
  for (int idx = tid; idx < 64 * 16; idx += NTHR) {
    const int r = idx >> 4, d8 = (idx & 15) * 8; const float pos = (float)(c * 64 + r);
    float q1[8], q2[8], k1[8], k2[8], oq1[8], oq2[8], ok1[8], ok2[8];
    const bf16_t* row = pj + (size_t)(t0 + r) * RET_IN + h * 256;
    unpack8(*(const uint4*)(row + d8), q1); unpack8(*(const uint4*)(row + 128 + d8), q2);
    unpack8(*(const uint4*)(row + 1024 + d8), k1); unpack8(*(const uint4*)(row + 1024 + 128 + d8), k2);
#pragma unroll
    for (int q = 0; q < 8; ++q) {
      float s, cs; rope_sincos(pos, d8 + q, s, cs);
      oq1[q] = q1[q] * cs - q2[q] * s; oq2[q] = q1[q] * s + q2[q] * cs;
      ok1[q] = (k1[q] * cs - k2[q] * s) * 0.0625f; ok2[q] = (k1[q] * s + k2[q] * cs) * 0.0625f;
    }
    *(uint4*)(qS + r * LD + d8) = pack8(oq1); *(uint4*)(qS + r * LD + 128 + d8) = pack8(oq2);
    *(uint4*)(kS + r * LD + d8) = pack8(ok1); *(uint4*)(kS + r * LD + 128 + d8) = pack8(ok2);
  }
  if (tid < 64) {
    const float lg = log1pf(-exp2f(-5.f - (float)h));
    gcS[tid] = (float)(tid + 1) * lg; jsS[tid] = 1.f; betaS[tid] = 0.f;
    if (tid == 63) ((float*)(p.ws + W_DEC))[6144 + it] = __expf(64.f * lg);
  }
  __syncthreads();
  qk_blobs<256>(qS, kS, gcS, jsS, betaS, Qg, KdT, QKd, nullptr);
  __syncthreads();
}

__device__ __forceinline__ void gdn_sample_item(const Params& p, int it, char* lds) {
  float* ks = (float*)lds; float* qs = ks + 128; float* vs = qs + 128; float* red = vs + 128;
  const int tid = tidx(), lane = tid & 63;
  const int b = it >> 3, h = it & 7; const int t = NPT + b;
  const bf16_t* xr = (const bf16_t*)(p.ws + W_XBC) + (size_t)t * CONV_CH;
  const float* scal = (const float*)(p.ws + W_SCAL) + (size_t)t * 48;
  if (tid < 128) { qs[tid] = bf2f(xr[h * 128 + tid]); ks[tid] = bf2f(xr[1024 + h * 128 + tid]); vs[tid] = bf2f(xr[2048 + h * 128 + tid]); }
  const float beta = scal[h], a = __expf(scal[8 + h]);
  __syncthreads();
  const int e4 = (tid & 31) * 4, dg = tid >> 5;
  const float* S0 = p.state_gdn + (size_t)(b * 8 + h) * 16384;
  float4 S[16]; float4 kS4 = make_float4(0, 0, 0, 0), qS4 = make_float4(0, 0, 0, 0);
#pragma unroll
  for (int i = 0; i < 16; ++i) {
    const int d = dg + 8 * i; S[i] = ldnt4(S0 + d * 128 + e4);
    const float kd = ks[d], qd = qs[d];
    kS4.x += kd * S[i].x; kS4.y += kd * S[i].y; kS4.z += kd * S[i].z; kS4.w += kd * S[i].w;
    qS4.x += qd * S[i].x; qS4.y += qd * S[i].y; qS4.z += qd * S[i].z; qS4.w += qd * S[i].w;
  }
  *(float4*)(red + dg * 128 + e4) = kS4; *(float4*)(red + 1024 + dg * 128 + e4) = qS4;
  float qk = wave_sum(qs[lane] * ks[lane] + qs[lane + 64] * ks[lane + 64]);
  __syncthreads();
  float4 kf = make_float4(0, 0, 0, 0), qf = make_float4(0, 0, 0, 0);
#pragma unroll
  for (int g = 0; g < 8; ++g) {
    float4 u = *(const float4*)(red + g * 128 + e4), v = *(const float4*)(red + 1024 + g * 128 + e4);
    kf.x += u.x; kf.y += u.y; kf.z += u.z; kf.w += u.w; qf.x += v.x; qf.y += v.y; qf.z += v.z; qf.w += v.w;
  }
  const float4 v4 = *(const float4*)(vs + e4);
  float4 u4 = make_float4(beta * (v4.x - a * kf.x), beta * (v4.y - a * kf.y), beta * (v4.z - a * kf.z), beta * (v4.w - a * kf.w));
  float* So = p.out + O_GDNS + (size_t)(b * 8 + h) * 16384;
#pragma unroll
  for (int i = 0; i < 16; ++i) {
    const int d = dg + 8 * i; const float kd = ks[d];
    stnt4(So + d * 128 + e4, make_float4(a * S[i].x + kd * u4.x, a * S[i].y + kd * u4.y, a * S[i].z + kd * u4.z, a * S[i].w + kd * u4.w));
  }
  if (dg == 0) {
    bf16_t* o = (bf16_t*)(p.ws + W_ORAW) + (size_t)t * 2048 + h * 128 + e4;
    *(uint2*)o = make_uint2(pk2(a * qf.x + qk * u4.x, a * qf.y + qk * u4.y), pk2(a * qf.z + qk * u4.z, a * qf.w + qk * u4.w));
  }
  __syncthreads();
}
__device__ __forceinline__ void ssd_sample_item(const Params& p, int it, char* lds) {
  float* ks = (float*)lds; float* qs = ks + 128; float* vs = qs + 128; float* red = vs + 64;
  const int tid = tidx();
  const int b = it >> 4, h = it & 15, g = h >> 3; const int t = NPT + b;
  const bf16_t* xr = (const bf16_t*)(p.ws + W_XBC) + (size_t)t * CONV_CH;
  const float* scal = (const float*)(p.ws + W_SCAL) + (size_t)t * 48;
  const float dt = scal[16 + h], a = __expf(scal[32 + h]);
  if (tid < 128) { ks[tid] = bf2f(xr[4096 + g * 128 + tid]) * dt; qs[tid] = bf2f(xr[4352 + g * 128 + tid]); }
  if (tid < 64) vs[tid] = bf2f(xr[3072 + h * 64 + tid]);
  __syncthreads();
  const int p4 = (tid & 15) * 4, ng = tid >> 4;
  const float* S0 = p.state_ssm + (size_t)(b * 16 + h) * 8192;
  float* So = p.out + O_SSMS + (size_t)(b * 16 + h) * 8192;
  const float4 v4 = *(const float4*)(vs + p4);
  float4 o4 = make_float4(0, 0, 0, 0);
#pragma unroll
  for (int i = 0; i < 8; ++i) {
    const int n = ng + 16 * i; float4 s = ldnt4(S0 + n * 64 + p4);
    const float kn = ks[n], qn = qs[n];
    s.x = a * s.x + kn * v4.x; s.y = a * s.y + kn * v4.y; s.z = a * s.z + kn * v4.z; s.w = a * s.w + kn * v4.w;
    stnt4(So + n * 64 + p4, s);
    o4.x += qn * s.x; o4.y += qn * s.y; o4.z += qn * s.z; o4.w += qn * s.w;
  }
  *(float4*)(red + ng * 64 + p4) = o4;
  __syncthreads();
  if (tid < 16) {
    float4 s = make_float4(0, 0, 0, 0);
#pragma unroll
    for (int gg = 0; gg < 16; ++gg) { float4 u = *(const float4*)(red + gg * 64 + tid * 4); s.x += u.x; s.y += u.y; s.z += u.z; s.w += u.w; }
    bf16_t* o = (bf16_t*)(p.ws + W_ORAW) + (size_t)t * 2048 + 1024 + h * 64 + tid * 4;
    *(uint2*)o = make_uint2(pk2(s.x, s.y), pk2(s.z, s.w));
  }
  __syncthreads();
}
__device__ __forceinline__ void ret_sample_item(const Params& p, int it, char* lds) {
  float* ks = (float*)lds; float* qs = ks + 256; float* vs = qs + 256; float* red = vs + 128;
  const int tid = tidx();
  const int sl = it & 3, bh = it >> 2, b = bh >> 2, h = bh & 3; const int t = NPT + b; const int e0 = sl * 128;
  const bf16_t* row = (const bf16_t*)(p.ws + W_PROJ1) + (size_t)t * RET_IN;
  {
    const int d = tid, dd = d & 127;
    float s, c; rope_sincos(16384.f, dd, s, c);
    const float q1 = bf2f(row[h * 256 + dd]), q2 = bf2f(row[h * 256 + 128 + dd]);
    const float k1 = bf2f(row[1024 + h * 256 + dd]), k2 = bf2f(row[1024 + h * 256 + 128 + dd]);
    qs[d] = d < 128 ? q1 * c - q2 * s : q1 * s + q2 * c;
    ks[d] = (d < 128 ? k1 * c - k2 * s : k1 * s + k2 * c) * 0.0625f;
    if (tid < 128) vs[tid] = bf2f(row[2048 + h * 512 + e0 + tid]);
  }
  __syncthreads();
  const float gamma = 1.f - exp2f(-5.f - (float)h);
  const int e4 = (tid & 31) * 4, dg = tid >> 5;
  const float* S0 = p.state_ret + (size_t)(b * 4 + h) * 131072 + e0;
  float* So = p.out + O_RETS + (size_t)(b * 4 + h) * 131072 + e0;
  const float4 v4 = *(const float4*)(vs + e4);
  float4 o4 = make_float4(0, 0, 0, 0);
#pragma unroll 8
  for (int i = 0; i < 32; ++i) {
    const int d = dg + 8 * i; float4 s = ldnt4(S0 + (size_t)d * 512 + e4);
    const float kn = ks[d], qn = qs[d];
    s.x = gamma * s.x + kn * v4.x; s.y = gamma * s.y + kn * v4.y; s.z = gamma * s.z + kn * v4.z; s.w = gamma * s.w + kn * v4.w;
    stnt4(So + (size_t)d * 512 + e4, s);
    o4.x += qn * s.x; o4.y += qn * s.y; o4.z += qn * s.z; o4.w += qn * s.w;
  }
  *(float4*)(red + dg * 128 + e4) = o4;
  __syncthreads();
  if (tid < 32) {
    float4 s = make_float4(0, 0, 0, 0);
#pragma unroll
    for (int gg = 0; gg < 8; ++gg) { float4 u = *(const float4*)(red + gg * 128 + tid * 4); s.x += u.x; s.y += u.y; s.z += u.z; s.w += u.w; }
    bf16_t* o = (bf16_t*)(p.ws + W_ORAW) + (size_t)t * 2048 + h * 512 + e0 + tid * 4;
    *(uint2*)o = make_uint2(pk2(s.x, s.y), pk2(s.z, s.w));
  }
  __syncthreads();
}

__device__ __forceinline__ void lds_barrier() { asm volatile("s_waitcnt lgkmcnt(0)\n\ts_barrier" ::: "memory"); }
template <int DK, int DVS, bool HAS_W>
__device__ __forceinline__ void scan_item(const char* blob0, size_t blob_stride, const float* dec,
                                          const bf16_t* U0, size_t u_stride, size_t u_cstride,
                                          bf16_t* O, size_t o_stride, float* Sout, int s_stride, char* lds) {
  constexpr int NT = DVS / 16, MT = DK / 64, KS = DK / 32, LS = DK + 8, LU = 72;
  bf16_t* Sbt = (bf16_t*)lds; bf16_t* Ubt = Sbt + DVS * LS;
  const int tid = tidx(), lane = tid & 63, w = tid >> 6, fr = lane & 15, fq = lane >> 4;
  f32x4 Sacc[MT][NT];
#pragma unroll
  for (int m = 0; m < MT; ++m)
#pragma unroll
    for (int n = 0; n < NT; ++n) Sacc[m][n] = (f32x4){0.f, 0.f, 0.f, 0.f};
  for (int i = tid; i < DVS * LS / 8; i += NTHR) ((uint4*)Sbt)[i] = make_uint4(0, 0, 0, 0);
  bf16_t u0r[NT][4]; bf16x8 wn[KS];
  {
    const bf16_t* Wn0 = (const bf16_t*)blob0 + 64 * DK + DK * 64 + 4096;
#pragma unroll
    for (int n = 0; n < NT; ++n)
#pragma unroll
      for (int jj = 0; jj < 4; ++jj) u0r[n][jj] = U0[(size_t)(16 * w + fq * 4 + jj) * u_stride + n * 16 + fr];
    if (HAS_W) {
#pragma unroll
      for (int ks = 0; ks < KS; ++ks) wn[ks] = ld16(Wn0 + (16 * w + fr) * DK + ks * 32 + fq * 8);
    }
  }
  __syncthreads();
#pragma unroll 1
  for (int c = 0; c < 32; ++c) {
    const bf16_t* Qg = (const bf16_t*)(blob0 + (size_t)c * blob_stride);
    const bf16_t* KdT = Qg + 64 * DK; const bf16_t* QKd = KdT + DK * 64;
    bf16x8 qg[KS], qkd[2], kdt[MT][2];
#pragma unroll
    for (int ks = 0; ks < KS; ++ks) qg[ks] = ld16(Qg + (16 * w + fr) * DK + ks * 32 + fq * 8);
#pragma unroll
    for (int ks = 0; ks < 2; ++ks) qkd[ks] = ld16(QKd + (16 * w + fr) * 64 + ks * 32 + fq * 8);
#pragma unroll
    for (int m = 0; m < MT; ++m)
#pragma unroll
      for (int ks = 0; ks < 2; ++ks) kdt[m][ks] = ld16(KdT + (w * (DK / 4) + m * 16 + fr) * 64 + ks * 32 + fq * 8);
    const float dc = dec[c];
    f32x4 Uacc[NT];
#pragma unroll
    for (int n = 0; n < NT; ++n)
#pragma unroll
      for (int jj = 0; jj < 4; ++jj) Uacc[n][jj] = bf2f(u0r[n][jj]);
    if (HAS_W) {
#pragma unroll
      for (int ks = 0; ks < KS; ++ks) {
#pragma unroll
        for (int n = 0; n < NT; ++n) { bf16x8 bb = *(const bf16x8*)(Sbt + (n * 16 + fr) * LS + ks * 32 + fq * 8); Uacc[n] = mfma16(wn[ks], bb, Uacc[n]); }
      }
    }
    {
      const int cn = (c + 1 < 32) ? c + 1 : c;
      const bf16_t* Wnn = (const bf16_t*)(blob0 + (size_t)cn * blob_stride) + 64 * DK + DK * 64 + 4096;
#pragma unroll
      for (int n = 0; n < NT; ++n)
#pragma unroll
        for (int jj = 0; jj < 4; ++jj) u0r[n][jj] = U0[(size_t)cn * u_cstride + (size_t)(16 * w + fq * 4 + jj) * u_stride + n * 16 + fr];
      if (HAS_W) {
#pragma unroll
        for (int ks = 0; ks < KS; ++ks) wn[ks] = ld16(Wnn + (16 * w + fr) * DK + ks * 32 + fq * 8);
      }
    }
#pragma unroll
    for (int n = 0; n < NT; ++n) *(uint2*)(Ubt + (n * 16 + fr) * LU + 16 * w + fq * 4) = make_uint2(pk2(Uacc[n][0], Uacc[n][1]), pk2(Uacc[n][2], Uacc[n][3]));
    lds_barrier();
    f32x4 Oacc[NT];
#pragma unroll
    for (int n = 0; n < NT; ++n) Oacc[n] = (f32x4){0.f, 0.f, 0.f, 0.f};
#pragma unroll
    for (int ks = 0; ks < KS; ++ks) {
#pragma unroll
      for (int n = 0; n < NT; ++n) { bf16x8 a = *(const bf16x8*)(Sbt + (n * 16 + fr) * LS + ks * 32 + fq * 8); Oacc[n] = mfma16(a, qg[ks], Oacc[n]); }
    }
    bf16x8 ub[2][NT];
#pragma unroll
    for (int ks = 0; ks < 2; ++ks)
#pragma unroll
      for (int n = 0; n < NT; ++n) ub[ks][n] = *(const bf16x8*)(Ubt + (n * 16 + fr) * LU + ks * 32 + fq * 8);
#pragma unroll
    for (int ks = 0; ks < 2; ++ks)
#pragma unroll
      for (int n = 0; n < NT; ++n) Oacc[n] = mfma16(ub[ks][n], qkd[ks], Oacc[n]);
#pragma unroll
    for (int n = 0; n < NT; ++n)
      *(uint2*)(O + (size_t)(c * 64 + 16 * w + fr) * o_stride + n * 16 + fq * 4) = make_uint2(pk2(Oacc[n][0], Oacc[n][1]), pk2(Oacc[n][2], Oacc[n][3]));
#pragma unroll
    for (int m = 0; m < MT; ++m)
#pragma unroll
      for (int n = 0; n < NT; ++n) Sacc[m][n] = Sacc[m][n] * dc;
#pragma unroll
    for (int ks = 0; ks < 2; ++ks)
#pragma unroll
      for (int m = 0; m < MT; ++m)
#pragma unroll
        for (int n = 0; n < NT; ++n) Sacc[m][n] = mfma16(kdt[m][ks], ub[ks][n], Sacc[m][n]);
    lds_barrier();
#pragma unroll
    for (int m = 0; m < MT; ++m)
#pragma unroll
      for (int n = 0; n < NT; ++n)
        *(uint2*)(Sbt + (n * 16 + fr) * LS + w * (DK / 4) + m * 16 + fq * 4) = make_uint2(pk2(Sacc[m][n][0], Sacc[m][n][1]), pk2(Sacc[m][n][2], Sacc[m][n][3]));
    lds_barrier();
  }
#pragma unroll
  for (int m = 0; m < MT; ++m)
#pragma unroll
    for (int n = 0; n < NT; ++n)
#pragma unroll
      for (int jj = 0; jj < 4; ++jj) Sout[(size_t)(w * (DK / 4) + m * 16 + fq * 4 + jj) * s_stride + n * 16 + fr] = Sacc[m][n][jj];
  __syncthreads();
}

__device__ __forceinline__ int queue_next(unsigned* ctr) {
  __shared__ int q_item;
  if (threadIdx.x == 0) q_item = (int)__hip_atomic_fetch_add(ctr, 1u, __ATOMIC_RELAXED, __HIP_MEMORY_SCOPE_AGENT);
  __syncthreads();
  const int it = q_item;
  __syncthreads();
  return it;
}
__device__ __forceinline__ void phase_prep_ab(const Params& p, char* lds) {
  const int NIT = 2048 + 4096;
  for (int it = blockIdx.x; it < NIT; it += gridDim.x) {
    if (it < 2048) gdn_prep_item(p, it, lds); else ssd_prep_item(p, it - 2048, lds);
  }
}
__device__ __forceinline__ void phase_scan_ab(const Params& p, char* lds) {
  constexpr int DVS = 64;
  const int N_G = 64 * (128 / DVS), N_S = 128 * (64 / DVS);
  bf16_t* oraw = (bf16_t*)(p.ws + W_ORAW);
  const float* dec = (const float*)(p.ws + W_DEC);
  const int half = gridDim.x >> 1;
  if ((int)blockIdx.x < half)
  for (int it = blockIdx.x; it < N_G + N_S; it += half) {
    if (it < N_G) {
      const int bh = it / (128 / DVS), sl = it % (128 / DVS), b = bh >> 3, h = bh & 7, e0 = sl * DVS;
      const char* blob0 = p.ws + W_GDNB + (size_t)(bh * 32) * GDN_BLOB;
      scan_item<128, DVS, true>(blob0, GDN_BLOB, dec + bh * 32, (const bf16_t*)(blob0 + 57344) + e0, 128, GDN_BLOB / 2,
                                oraw + (size_t)(b * SEQ) * 2048 + h * 128 + e0, 2048,
                                p.out + O_GDNP + (size_t)bh * 16384 + e0, 128, lds);
    } else {
      const int r = it - N_G; const int bh = r / (64 / DVS), sl = r % (64 / DVS), b = bh >> 4, h = bh & 15, e0 = sl * DVS;
      const char* blob0 = p.ws + W_SSDB + (size_t)(bh * 32) * SSD_BLOB;
      scan_item<128, DVS, false>(blob0, SSD_BLOB, dec + 2048 + bh * 32,
                                 (const bf16_t*)(p.ws + W_XBC) + (size_t)(b * SEQ) * CONV_CH + 3072 + h * 64 + e0, CONV_CH, (size_t)64 * CONV_CH,
                                 oraw + (size_t)(b * SEQ) * 2048 + 1024 + h * 64 + e0, 2048,
                                 p.out + O_SSMP + (size_t)bh * 8192 + e0, 64, lds);
    }
  }
  unsigned* qctr = (unsigned*)(p.ws + W_BAR) + 8;
  for (;;) {
    const int it = queue_next(qctr);
    if (it >= 1024 + 2048) break;
    if (it < 1024) gdn_sample_item(p, it, lds); else ssd_sample_item(p, it - 1024, lds);
  }
}
__device__ __forceinline__ void phase_prep_ret(const Params& p, char* lds) {
  for (int it = blockIdx.x; it < 1024; it += gridDim.x) ret_prep_item(p, it, lds);
}
__device__ __forceinline__ void phase_scan_ret(const Params& p, char* lds) {
  constexpr int DVS = 64;
  const int NS = 512 / DVS;
  bf16_t* oraw = (bf16_t*)(p.ws + W_ORAW);
  const float* dec = (const float*)(p.ws + W_DEC) + 6144;
  const int half = gridDim.x >> 1;
  if ((int)blockIdx.x < half)
  for (int it = blockIdx.x; it < 32 * NS; it += half) {
    const int bh = it / NS, sl = it % NS, b = bh >> 2, h = bh & 3, e0 = sl * DVS;
    const char* blob0 = p.ws + W_RETB + (size_t)(bh * 32) * RET_BLOB;
    scan_item<256, DVS, false>(blob0, RET_BLOB, dec + bh * 32,
                               (const bf16_t*)(p.ws + W_PROJ1) + (size_t)(b * SEQ) * RET_IN + 2048 + h * 512 + e0, RET_IN, (size_t)64 * RET_IN,
                               oraw + (size_t)(b * SEQ) * 2048 + h * 512 + e0, 2048,
                               p.out + O_RETP + (size_t)bh * 131072 + e0, 512, lds);
  }
  unsigned* qctr = (unsigned*)(p.ws + W_BAR) + 24;
  for (;;) {
    const int it = queue_next(qctr);
    if (it >= 2048) break;
    ret_sample_item(p, it, lds);
  }
}

__device__ __forceinline__ void phase_post_ab(const Params& p) {
  const int lane = tidx() & 63, wave = tidx() >> 6;
  const bf16_t* oraw = (const bf16_t*)(p.ws + W_ORAW); const bf16_t* gz = (const bf16_t*)(p.ws + W_GZ);
  const bf16_t* xbc = (const bf16_t*)(p.ws + W_XBC); bf16_t* a2 = (bf16_t*)(p.ws + W_A2);
  for (int t = blockIdx.x * 4 + wave; t < NTOK; t += gridDim.x * 4) {
#pragma unroll
    for (int j = 0; j < 2; ++j) {
      const int c = j * 512 + lane * 8;
      float o[8], gt[8], gn[8];
      unpack8(ldnt_u4(oraw + (size_t)t * 2048 + c), o); unpack8(ldnt_u4(gz + (size_t)t * GZ_W + c), gt);
      load8f(p.gdn_norm_g + (c & 127), gn);
      float ss = 0.f;
#pragma unroll
      for (int i = 0; i < 8; ++i) ss += o[i] * o[i];
      ss = grp16_sum(ss);
      const float rstd = rsqrtf(ss * (1.f / 128.f) + 1e-6f);
#pragma unroll
      for (int i = 0; i < 8; ++i) o[i] = o[i] * rstd * gn[i] * siluf_(gt[i]);
      *(uint4*)(a2 + (size_t)t * 2048 + c) = pack8(o);
    }
    float ob[16]; float ss = 0.f;
#pragma unroll
    for (int j = 0; j < 2; ++j) {
      const int c = j * 512 + lane * 8;
      float o[8], xs[8], z[8];
      unpack8(ldnt_u4(oraw + (size_t)t * 2048 + 1024 + c), o); unpack8(ldnt_u4(xbc + (size_t)t * CONV_CH + 3072 + c), xs);
      unpack8(ldnt_u4(gz + (size_t)t * GZ_W + 1024 + c), z);
      const float dd = p.ssm_d[c >> 6];
#pragma unroll
      for (int i = 0; i < 8; ++i) { float v = (o[i] + dd * xs[i]) * siluf_(z[i]); ob[j * 8 + i] = v; ss += v * v; }
    }
    ss = wave_sum(ss);
    const float rstd = rsqrtf(ss * (1.f / 1024.f) + 1e-6f);
#pragma unroll
    for (int j = 0; j < 2; ++j) {
      const int c = j * 512 + lane * 8;
      float gn[8], o[8]; load8f(p.ssm_norm_g + c, gn);
#pragma unroll
      for (int i = 0; i < 8; ++i) o[i] = ob[j * 8 + i] * rstd * gn[i];
      *(uint4*)(a2 + (size_t)t * 2048 + 1024 + c) = pack8(o);
    }
  }
}
__device__ __forceinline__ void phase_post_ret(const Params& p) {
  const int lane = tidx() & 63, wave = tidx() >> 6;
  const bf16_t* oraw = (const bf16_t*)(p.ws + W_ORAW); const bf16_t* pj = (const bf16_t*)(p.ws + W_PROJ1); bf16_t* a2 = (bf16_t*)(p.ws + W_A2);
  for (int t = blockIdx.x * 4 + wave; t < NTOK; t += gridDim.x * 4) {
#pragma unroll
    for (int h = 0; h < 4; ++h) {
      const int c = h * 512 + lane * 8;
      float o[8], gt[8], gn[8];
      unpack8(ldnt_u4(oraw + (size_t)t * 2048 + c), o); unpack8(ldnt_u4(pj + (size_t)t * RET_IN + 4096 + c), gt);
      load8f(p.ret_norm_g + c, gn);
      float s = 0.f;
#pragma unroll
      for (int i = 0; i < 8; ++i) s += o[i];
      const float mu = wave_sum(s) * (1.f / 512.f);
      float vs = 0.f;
#pragma unroll
      for (int i = 0; i < 8; ++i) { o[i] -= mu; vs += o[i] * o[i]; }
      const float rstd = rsqrtf(wave_sum(vs) * (1.f / 512.f) + 1e-6f);
#pragma unroll
      for (int i = 0; i < 8; ++i) o[i] = o[i] * rstd * gn[i] * siluf_(gt[i]);
      *(uint4*)(a2 + (size_t)t * 2048 + c) = pack8(o);
    }
  }
}

__device__ __forceinline__ void phase_topk(const Params& p, int layer, char* lds) {
  float* sc = (float*)lds;
  float* tkv = sc + 128 * 129;
  unsigned char* tki = (unsigned char*)(tkv + 128 * 16);
  const int tid = tidx(), lane = tid & 63, w = tid >> 6, fr = lane & 15, fq = lane >> 4;
  const bf16_t* qb = (const bf16_t*)(p.ws + W_ORAW);
  const bf16_t* keys = (const bf16_t*)(p.ws + W_KEYS) + (size_t)layer * 2 * 128 * 128;
  int* oidx = (int*)(p.ws + W_TKI); float* ogate = (float*)(p.ws + W_TKG);
  for (int item = blockIdx.x; item < 258 * 8; item += gridDim.x) {
    const int tt = item >> 3, h = item & 7, t0 = tt * 64;
#pragma unroll 1
    for (int pp = 0; pp < 2; ++pp) {
      f32x4 acc[8];
#pragma unroll
      for (int n = 0; n < 8; ++n) acc[n] = (f32x4){0.f, 0.f, 0.f, 0.f};
#pragma unroll
      for (int ks = 0; ks < 4; ++ks) {
        bf16x8 bq = ld16(qb + (size_t)(t0 + 16 * w + fr) * 2048 + h * 256 + pp * 128 + ks * 32 + fq * 8);
#pragma unroll
        for (int n = 0; n < 8; ++n) { bf16x8 a = ld16(keys + (size_t)(pp * 128 + n * 16 + fr) * 128 + ks * 32 + fq * 8); acc[n] = mfma16(a, bq, acc[n]); }
      }
#pragma unroll
      for (int n = 0; n < 8; ++n)
#pragma unroll
        for (int jj = 0; jj < 4; ++jj) sc[((16 * w + fr) * 2 + pp) * 129 + n * 16 + fq * 4 + jj] = acc[n][jj];
    }
    __syncthreads();
    {
      const int row = tid >> 1, hf = tid & 1; float* r = sc + row * 129 + hf;
      float gmax[8];
#pragma unroll
      for (int g = 0; g < 8; ++g) {
        float m = r[2 * (8 * g)];
#pragma unroll
        for (int i = 1; i < 8; ++i) m = fmaxf(m, r[2 * (8 * g + i)]);
        gmax[g] = m;
      }
#pragma unroll 1
      for (int it = 0; it < 16; ++it) {
        float best = gmax[0]; int bg = 0;
#pragma unroll
        for (int g = 1; g < 8; ++g) if (gmax[g] > best) { best = gmax[g]; bg = g; }
        int bj = 8 * bg + 7;
#pragma unroll
        for (int i = 6; i >= 0; --i) if (r[2 * (8 * bg + i)] == best) bj = 8 * bg + i;
        int bi = 2 * bj + hf;
        const float ov = __shfl_xor(best, 1); const int oi = __shfl_xor(bi, 1);
        const bool take = (ov > best) || (ov == best && oi < bi);
        if (!take) {
          r[2 * bj] = -INFINITY;
          float m = r[2 * (8 * bg)];
#pragma unroll
          for (int i = 1; i < 8; ++i) m = fmaxf(m, r[2 * (8 * bg + i)]);
#pragma unroll
          for (int g = 0; g < 8; ++g) if (g == bg) gmax[g] = m;
        }
        if (hf == 0) { tkv[row * 16 + it] = take ? ov : best; tki[row * 16 + it] = (unsigned char)(take ? oi : bi); }
      }
    }
    __syncthreads();
    {
      const int tok = tid >> 2, qd = tid & 3;
      const float* v0 = tkv + (tok * 2) * 16; const float* v1 = v0 + 16;
      float a0[4]; int ptr[4];
#pragma unroll
      for (int i = 0; i < 4; ++i) { a0[i] = v0[qd * 4 + i]; ptr[i] = 0; }
      float cv[16]; int ci[16];
#pragma unroll
      for (int it = 0; it < 16; ++it) {
        float best = -INFINITY; int bidx = 1 << 30;
#pragma unroll
        for (int i = 0; i < 4; ++i) {
          const float cnd = (ptr[i] < 16) ? a0[i] + v1[ptr[i] & 15] : -INFINITY; const int fi = (qd * 4 + i) * 16 + ptr[i];
          if (cnd > best || (cnd == best && fi < bidx)) { best = cnd; bidx = fi; }
        }
#pragma unroll
        for (int off = 1; off < 4; off <<= 1) {
          const float ov = __shfl_xor(best, off); const int oi = __shfl_xor(bidx, off);
          if (ov > best || (ov == best && oi < bidx)) { best = ov; bidx = oi; }
        }
        const int wa = bidx >> 4;
#pragma unroll
        for (int i = 0; i < 4; ++i) if (wa == qd * 4 + i) ptr[i]++;
        cv[it] = best; ci[it] = bidx;
      }
      const float m = cv[0];
      float ev[16]; float es = 0.f;
#pragma unroll
      for (int it = 0; it < 16; ++it) { ev[it] = __expf(cv[it] - m); es += ev[it]; }
      const float inv = 1.f / es;
      const unsigned char* i0 = tki + (tok * 2) * 16; const unsigned char* i1 = i0 + 16;
      const size_t ob = ((size_t)(t0 + tok) * 8 + h) * 16;
#pragma unroll
      for (int it = 0; it < 16; ++it) {
        if ((it >> 2) == qd) { oidx[ob + it] = (int)i0[ci[it] >> 4] * 128 + (int)i1[ci[it] & 15]; ogate[ob + it] = ev[it] * inv; }
      }
    }
    __syncthreads();
  }
}

__device__ __forceinline__ void deq16(uint4 r, f32x2_t* f) {
  f[0] = __builtin_amdgcn_cvt_pk_f32_fp8((int)r.x, false); f[1] = __builtin_amdgcn_cvt_pk_f32_fp8((int)r.x, true);
  f[2] = __builtin_amdgcn_cvt_pk_f32_fp8((int)r.y, false); f[3] = __builtin_amdgcn_cvt_pk_f32_fp8((int)r.y, true);
  f[4] = __builtin_amdgcn_cvt_pk_f32_fp8((int)r.z, false); f[5] = __builtin_amdgcn_cvt_pk_f32_fp8((int)r.z, true);
  f[6] = __builtin_amdgcn_cvt_pk_f32_fp8((int)r.w, false); f[7] = __builtin_amdgcn_cvt_pk_f32_fp8((int)r.w, true);
}
__device__ __forceinline__ void gather_groups(const unsigned char* U, const unsigned char* V, const bf16_t* hm, const int* tki, const float* tkg,
                                              int t, int gb, int ge, int lane, f32x2_t* y) {
  f32x2_t xv[8];
  {
    float f[16];
    unpack8(*(const uint4*)(hm + (size_t)t * D + lane * 16), f); unpack8(*(const uint4*)(hm + (size_t)t * D + lane * 16 + 8), f + 8);
#pragma unroll
    for (int i = 0; i < 8; ++i) xv[i] = (f32x2_t){f[2 * i], f[2 * i + 1]};
  }
  const int id0 = tki[(size_t)t * 128 + lane], id1 = tki[(size_t)t * 128 + 64 + lane];
  const float g0 = tkg[(size_t)t * 128 + lane], g1 = tkg[(size_t)t * 128 + 64 + lane];
  uint4 ra[8], rb[8]; int rida[8], ridb[8]; float gta[8], gtb[8];
#define G_LOADU(R, RID, GT, g) _Pragma("unroll") for (int e = 0; e < 8; ++e) { \
    const int k = ((g) * 8 + e) & 63; \
    RID[e] = __builtin_amdgcn_readlane((g) < 8 ? id0 : id1, k); \
    R[e] = *(const uint4*)(U + (size_t)RID[e] * 1024 + lane * 16); }
#define G_DOTS(R, RID, GT, g) { float dl = 0.f; \
    _Pragma("unroll") for (int e = 0; e < 8; ++e) { \
      f32x2_t f[8]; deq16(R[e], f); f32x2_t d2 = f[0] * xv[0]; \
      _Pragma("unroll") for (int i = 1; i < 8; ++i) d2 += f[i] * xv[i]; \
      const float d = wave_sum_fast(d2[0] + d2[1]); \
      dl = (lane == (((g) * 8 + e) & 63)) ? d : dl; \
      R[e] = *(const uint4*)(V + (size_t)RID[e] * 1024 + lane * 16); } \
    const float al = geluf_(dl * (1.f / U_SCALE)) * ((g) < 8 ? g0 : g1) * (1.f / V_SCALE);     \
    _Pragma("unroll") for (int e = 0; e < 8; ++e) GT[e] = __int_as_float(__builtin_amdgcn_readlane(__float_as_int(al), ((g) * 8 + e) & 63)); }
#define G_ACC(R, GT) _Pragma("unroll") for (int e = 0; e < 8; ++e) { \
    f32x2_t f[8]; deq16(R[e], f); const f32x2_t a2 = (f32x2_t){GT[e], GT[e]}; \
    _Pragma("unroll") for (int i = 0; i < 8; ++i) y[i] += a2 * f[i]; }
  G_LOADU(ra, rida, gta, gb)
#pragma unroll 1
  for (int g = gb; g < ge; g += 2) {
    G_DOTS(ra, rida, gta, g)
    G_LOADU(rb, ridb, gtb, g + 1)
    __builtin_amdgcn_sched_barrier(0);
    G_ACC(ra, gta)
    G_DOTS(rb, ridb, gtb, g + 1)
    if (g + 2 < ge) { G_LOADU(ra, rida, gta, g + 2) }
    __builtin_amdgcn_sched_barrier(0);
    G_ACC(rb, gtb)
  }
#undef G_LOADU
#undef G_DOTS
#undef G_ACC
}
__device__ __forceinline__ void gather_epilogue(const Params& p, int layer, int t, const f32x2_t* y, int lane) {
  bf16_t* hm = (bf16_t*)(p.ws + W_HM);
  float* xws = (float*)(p.ws + W_X);
  const float* mod = (const float*)(p.ws + W_MOD);
  const int c0 = lane * 16;
  const float* mr = mod + (size_t)seq_row(t) * 12288 + layer * 6144;
  float xr[16]; float ss = 0.f;
  {
    float xo[16], g2[16];
    load8f(xws + (size_t)t * D + c0, xo); load8f(xws + (size_t)t * D + c0 + 8, xo + 8);
    load8f(mr + 5 * 1024 + c0, g2); load8f(mr + 5 * 1024 + c0 + 8, g2 + 8);
#pragma unroll
    for (int i = 0; i < 16; ++i) { const float v = xo[i] + g2[i] * y[i >> 1][i & 1]; xr[i] = v; ss += v * v; }
  }
  ss = wave_sum(ss);
  const float rstd = rsqrtf(ss * (1.f / D) + 1e-6f);
  if (layer == 0) {
    store8f(xws + (size_t)t * D + c0, xr); store8f(xws + (size_t)t * D + c0 + 8, xr + 8);
    const float* m1 = mod + (size_t)seq_row(t) * 12288 + 6144;
    float gg[16], s1[16], s2[16], o[16];
    load8f(p.norm1_g + D + c0, gg); load8f(p.norm1_g + D + c0 + 8, gg + 8);
    load8f(m1 + 1024 + c0, s1); load8f(m1 + 1024 + c0 + 8, s1 + 8);
    load8f(m1 + c0, s2); load8f(m1 + c0 + 8, s2 + 8);
#pragma unroll
    for (int i = 0; i < 16; ++i) o[i] = xr[i] * rstd * gg[i] * (1.f + s1[i]) + s2[i];
    *(uint4*)(hm + (size_t)t * D + c0) = pack8(o); *(uint4*)(hm + (size_t)t * D + c0 + 8) = pack8(o + 8);
  } else {
    float gg[16], o[16];
    load8f(p.final_g + c0, gg); load8f(p.final_g + c0 + 8, gg + 8);
#pragma unroll
    for (int i = 0; i < 16; ++i) o[i] = xr[i] * rstd * gg[i];
    { float* yo = p.out + O_Y + (size_t)t * D + c0;
      stnt4(yo, make_float4(o[0], o[1], o[2], o[3])); stnt4(yo + 4, make_float4(o[4], o[5], o[6], o[7]));
      stnt4(yo + 8, make_float4(o[8], o[9], o[10], o[11])); stnt4(yo + 12, make_float4(o[12], o[13], o[14], o[15])); }
  }
}
__device__ __forceinline__ void phase_gather(const Params& p, int layer, char* lds) {
  const int lane = tidx() & 63, wave = tidx() >> 6;
  const unsigned char* U = (const unsigned char*)(p.ws + W_U) + (size_t)layer * 16384 * 1024;
  const unsigned char* V = (const unsigned char*)(p.ws + W_V) + (size_t)layer * 16384 * 1024;
  const bf16_t* hm = (const bf16_t*)(p.ws + W_HM);
  const int* tki = (const int*)(p.ws + W_TKI); const float* tkg = (const float*)(p.ws + W_TKG);
  for (int t = blockIdx.x * 4 + wave; t < NPT; t += gridDim.x * 4) {
    f32x2_t y[8];
#pragma unroll
    for (int i = 0; i < 8; ++i) y[i] = (f32x2_t){0.f, 0.f};
    gather_groups(U, V, hm, tki, tkg, t, 0, 16, lane, y);
    gather_epilogue(p, layer, t, y, lane);
  }
  float* part = (float*)lds;
  for (int tt = blockIdx.x; tt < NTOK - NPT; tt += gridDim.x) {
    const int t = NPT + tt;
    f32x2_t y[8];
#pragma unroll
    for (int i = 0; i < 8; ++i) y[i] = (f32x2_t){0.f, 0.f};
    gather_groups(U, V, hm, tki, tkg, t, wave * 4, wave * 4 + 4, lane, y);
#pragma unroll
    for (int i = 0; i < 8; ++i) *(f32x2_t*)(part + wave * 1024 + lane * 16 + 2 * i) = y[i];
    __syncthreads();
    if (wave == 0) {
#pragma unroll
      for (int i = 0; i < 8; ++i) {
        f32x2_t a = *(const f32x2_t*)(part + lane * 16 + 2 * i);
        a += *(const f32x2_t*)(part + 1024 + lane * 16 + 2 * i); a += *(const f32x2_t*)(part + 2048 + lane * 16 + 2 * i); a += *(const f32x2_t*)(part + 3072 + lane * 16 + 2 * i);
        y[i] = a;
      }
      gather_epilogue(p, layer, t, y, lane);
    }
    __syncthreads();
  }
}

#define XB_TMO      128
#define XB_XCNT(j)  (256  + 64 * (j))
#define XB_XSUB(j)  (1280 + 64 * (j))
#define XB_XGEN(j)  (2304 + 64 * (j))
#define XB_TOP      3328
#define XB_TOPGEN   3392
#define XCD_BAR_WORDS 3456
#define XB_SPIN_CAP (1u << 22)
#define LAS __attribute__((address_space(3)))
__device__ __forceinline__ unsigned xb_ld(unsigned* p)              { return __hip_atomic_load(p, __ATOMIC_RELAXED, __HIP_MEMORY_SCOPE_AGENT); }
__device__ __forceinline__ unsigned xb_add(unsigned* p, unsigned v) { return __hip_atomic_fetch_add(p, v, __ATOMIC_RELAXED, __HIP_MEMORY_SCOPE_AGENT); }
__device__ __forceinline__ unsigned xb_xcc_id() { return (unsigned)__builtin_amdgcn_s_getreg((3 << 11) | 20) & 0xFu; }
#define XB_SPIN(cond, bar) do { unsigned _sp = 0; while (cond) { __builtin_amdgcn_s_sleep(1); \
    if ((++_sp & 255u) == 0u) { if (xb_ld(&(bar)[XB_TMO])) break; if (_sp > XB_SPIN_CAP) { atomicAdd(&(bar)[XB_TMO], 1u); break; } } } } while (0)
struct XcdBarrier { unsigned* bar; unsigned x; volatile unsigned* st; };
__device__ __forceinline__ XcdBarrier xcd_barrier_post(unsigned* bar, volatile unsigned* st) {
  XcdBarrier b; b.bar = bar; b.x = xb_xcc_id(); b.st = st;
  if (threadIdx.x == 0) (void)xb_add(&bar[XB_XCNT(b.x)], 1u);
  return b;
}
__device__ __forceinline__ void xcd_barrier_complete(unsigned* bar, unsigned x, unsigned& nloc, unsigned& nx) {
  const unsigned G = gridDim.x;
  unsigned sum, cnt, mine, sp = 0u;
  for (;;) {
    sum = 0u; cnt = 0u; mine = 0u;
#pragma unroll
    for (unsigned j = 0; j < 16; ++j) { const unsigned c = xb_ld(&bar[XB_XCNT(j)]); sum += c; cnt += (c > 0u) ? 1u : 0u; mine = (j == x) ? c : mine; }
    if (sum == G) break;
    __builtin_amdgcn_s_sleep(1);
    if ((++sp & 255u) == 0u) { if (xb_ld(&bar[XB_TMO])) break; if (sp > XB_SPIN_CAP) { atomicAdd(&bar[XB_TMO], 1u); break; } }
  }
  nloc = mine > 0u ? mine : 1u; nx = cnt > 0u ? cnt : 1u;
}
__device__ __forceinline__ void xcd_barrier(const XcdBarrier& b) {
  asm volatile("s_waitcnt vmcnt(0)" ::: "memory");
  __syncthreads();
  if (threadIdx.x == 0) {
    unsigned* bar = b.bar;
    __builtin_amdgcn_s_waitcnt(0);
    unsigned nloc = b.st[0], nx = b.st[1];
    if (nloc == 0u) { xcd_barrier_complete(bar, b.x, nloc, nx); b.st[0] = nloc; b.st[1] = nx; }
    const unsigned old = xb_add(&bar[XB_XSUB(b.x)], 1u);
    const unsigned gen = old / nloc;
    if (old + 1u == (gen + 1u) * nloc) {
      __builtin_amdgcn_fence(__ATOMIC_RELEASE, "agent");
      asm volatile("s_waitcnt vmcnt(0)" ::: "memory");
      const unsigned og = xb_add(&bar[XB_TOP], 1u);
      const unsigned tg = og / nx;
      if (og + 1u == (tg + 1u) * nx) xb_add(&bar[XB_TOPGEN], 1u);
      else XB_SPIN(xb_ld(&bar[XB_TOPGEN]) == tg, bar);
      __builtin_amdgcn_fence(__ATOMIC_ACQUIRE, "agent");
      xb_add(&bar[XB_XGEN(b.x)], 1u);
      asm volatile("s_waitcnt vmcnt(0)" ::: "memory");
    } else {
      XB_SPIN(xb_ld(&bar[XB_XGEN(b.x)]) == gen, bar);
      __builtin_amdgcn_fence(__ATOMIC_ACQUIRE, "agent");
      asm volatile("s_waitcnt vmcnt(0)" ::: "memory");
    }
  }
  __syncthreads();
}

__device__ __forceinline__ void gsync(cg::grid_group& grid) {
  __threadfence();
  grid.sync();
  __builtin_amdgcn_fence(__ATOMIC_ACQUIRE, "agent");
  asm volatile("s_waitcnt vmcnt(0)" ::: "memory");
}
__device__ __forceinline__ void zfill(float* o, size_t a, size_t b) {
  for (size_t i = a + (size_t)blockIdx.x * NTHR + tidx(); i < b; i += (size_t)gridDim.x * NTHR) o[i] = 0.f;
}
__global__ void __launch_bounds__(NTHR, 2) mega(Params p) {
  __shared__ __attribute__((aligned(16))) char lds[LDS_BYTES];
  __shared__ uint4 xb_words;
  if (threadIdx.x == 0) xb_words = make_uint4(0u, 0u, 0u, 0u);
  __syncthreads();
  const XcdBarrier xb = xcd_barrier_post((unsigned*)(p.ws + W_BAR), (volatile unsigned*)&xb_words);
  char* ws = p.ws;
  float* mod = (float*)(ws + W_MOD);
  bf16_t* hm = (bf16_t*)(ws + W_HM);
  float* xws = (float*)(ws + W_X);

#pragma unroll 1
  for (int rep = 0; rep < REP_P0; ++rep)
    phase_prep(p, lds);
  xcd_barrier(xb);
#if STOP_AFTER == 1
  zfill(p.out, O_Y, O_CONVP); zfill(p.out, O_GDNS, O_RETS); zfill(p.out, O_GDNP, O_RETP); zfill(p.out, O_RETS, O_RETS + 67108864); zfill(p.out, O_RETP, O_CONVS);
  return;
#endif
#pragma unroll 1
  for (int rep = 0; rep < REP_SYNC; ++rep) xcd_barrier(xb);
  gemm_phase((const bf16_t*)(ws + W_SILUC), (const bf16_t*)(ws + W_ADA_T), NSEQ, 12288, 1024, lds, EpiMod{mod, p.ada_b});
  xcd_barrier(xb);
#if STOP_AFTER == 2
  zfill(p.out, O_Y, O_CONVP); zfill(p.out, O_GDNS, O_RETS); zfill(p.out, O_GDNP, O_RETP); zfill(p.out, O_RETS, O_RETS + 67108864); zfill(p.out, O_RETP, O_CONVS);
  return;
#endif
#pragma unroll 1
  for (int rep = 0; rep < REP_ELT; ++rep)
    phase_adaln(p, 0, 0, true);
  xcd_barrier(xb);
#if STOP_AFTER == 3
  zfill(p.out, O_Y, O_CONVP); zfill(p.out, O_GDNS, O_RETS); zfill(p.out, O_GDNP, O_RETP); zfill(p.out, O_RETS, O_RETS + 67108864); zfill(p.out, O_RETP, O_CONVS);
  return;
#endif
#pragma unroll 1
  for (int rep = 0; rep < REP_GEMM; ++rep)
  gemm_phase(hm, (const bf16_t*)(ws + W_IN0_T), NTOK, AB_IN, 1024, lds, EpiProj0{(bf16_t*)(ws + W_PRE), (bf16_t*)(ws + W_GZ)});
  xcd_barrier(xb);
#if STOP_AFTER == 4
  zfill(p.out, O_Y, O_CONVP); zfill(p.out, O_GDNS, O_RETS); zfill(p.out, O_GDNP, O_RETP); zfill(p.out, O_RETS, O_RETS + 67108864); zfill(p.out, O_RETP, O_CONVS);
  return;
#endif
#pragma unroll 1
  for (int rep = 0; rep < REP_ELT; ++rep)
    phase_conv(p);
  xcd_barrier(xb);
#if STOP_AFTER == 5
  zfill(p.out, O_Y, O_CONVP); zfill(p.out, O_GDNS, O_RETS); zfill(p.out, O_GDNP, O_RETP); zfill(p.out, O_RETS, O_RETS + 67108864); zfill(p.out, O_RETP, O_CONVS);
  return;
#endif
#pragma unroll 1
  for (int rep = 0; rep < REP_PREP; ++rep)
    phase_prep_ab(p, lds);
  xcd_barrier(xb);
#if STOP_AFTER == 6
  zfill(p.out, O_Y, O_CONVP); zfill(p.out, O_GDNP, O_RETP); zfill(p.out, O_RETS, O_RETS + 67108864); zfill(p.out, O_RETP, O_CONVS);
  return;
#endif
#pragma unroll 1
  for (int rep = 0; rep < REP_SCAN; ++rep)
    phase_scan_ab(p, lds);
  xcd_barrier(xb);
#if STOP_AFTER == 7
  zfill(p.out, O_Y, O_CONVP); zfill(p.out, O_RETS, O_RETS + 67108864); zfill(p.out, O_RETP, O_CONVS);
  return;
#endif
#pragma unroll 1
  for (int rep = 0; rep < REP_ELT; ++rep)
    phase_post_ab(p);
  xcd_barrier(xb);
#if STOP_AFTER == 8
  zfill(p.out, O_Y, O_CONVP); zfill(p.out, O_RETS, O_RETS + 67108864); zfill(p.out, O_RETP, O_CONVS);
  return;
#endif
#pragma unroll 1
  for (int rep = 0; rep < REP_GEMM; ++rep)
  gemm_phase((const bf16_t*)(ws + W_A2), (const bf16_t*)(ws + W_OUT0_T), NTOK, 1024, 2048, lds, EpiRes{p.x_prompt, p.x_sample, mod + 2048, xws, 1});
  xcd_barrier(xb);
#if STOP_AFTER == 9
  zfill(p.out, O_Y, O_CONVP); zfill(p.out, O_RETS, O_RETS + 67108864); zfill(p.out, O_RETP, O_CONVS);
  return;
#endif
#pragma unroll 1
  for (int rep = 0; rep < REP_ELT; ++rep)
    phase_adaln(p, 0, 1, false);
  xcd_barrier(xb);
#if STOP_AFTER == 10
  zfill(p.out, O_Y, O_CONVP); zfill(p.out, O_RETS, O_RETS + 67108864); zfill(p.out, O_RETP, O_CONVS);
  return;
#endif
#pragma unroll 1
  for (int rep = 0; rep < REP_GEMM; ++rep)
  gemm_phase(hm, (const bf16_t*)(ws + W_Q_T), NTOK, 2048, 1024, lds, EpiBf{(bf16_t*)(ws + W_ORAW), 2048});
  xcd_barrier(xb);
#if STOP_AFTER == 11
  zfill(p.out, O_Y, O_CONVP); zfill(p.out, O_RETS, O_RETS + 67108864); zfill(p.out, O_RETP, O_CONVS);
  return;
#endif
#pragma unroll 1
  for (int rep = 0; rep < REP_TOPK; ++rep) phase_topk(p, 0, lds);
  xcd_barrier(xb);
#if STOP_AFTER == 12
  zfill(p.out, O_Y, O_CONVP); zfill(p.out, O_RETS, O_RETS + 67108864); zfill(p.out, O_RETP, O_CONVS);
  return;
#endif
  phase_gather(p, 0, lds);
  xcd_barrier(xb);
#if STOP_AFTER == 13
  zfill(p.out, O_Y, O_CONVP); zfill(p.out, O_RETS, O_RETS + 67108864); zfill(p.out, O_RETP, O_CONVS);
  return;
#endif
#pragma unroll 1
  for (int rep = 0; rep < REP_GEMM; ++rep)
  gemm_phase(hm, (const bf16_t*)(ws + W_IN1_T), NTOK, RET_IN, 1024, lds, EpiBf{(bf16_t*)(ws + W_PROJ1), RET_IN});
  xcd_barrier(xb);
#if STOP_AFTER == 14
  zfill(p.out, O_Y, O_CONVP); zfill(p.out, O_RETS, O_RETS + 67108864); zfill(p.out, O_RETP, O_CONVS);
  return;
#endif
#pragma unroll 1
  for (int rep = 0; rep < REP_PREP; ++rep)
    phase_prep_ret(p, lds);
  xcd_barrier(xb);
#if STOP_AFTER == 15
  zfill(p.out, O_Y, O_CONVP); zfill(p.out, O_RETP, O_CONVS);
  return;
#endif
#pragma unroll 1
  for (int rep = 0; rep < REP_SCAN; ++rep)
    phase_scan_ret(p, lds);
  xcd_barrier(xb);
#if STOP_AFTER == 16
  zfill(p.out, O_Y, O_CONVP);
  return;
#endif
#pragma unroll 1
  for (int rep = 0; rep < REP_ELT; ++rep)
    phase_post_ret(p);
  xcd_barrier(xb);
#if STOP_AFTER == 17
  zfill(p.out, O_Y, O_CONVP);
  return;
#endif
  gemm_phase((const bf16_t*)(ws + W_A2), (const bf16_t*)(ws + W_OUT1_T), NTOK, 1024, 2048, lds, EpiRes{p.x_prompt, p.x_sample, mod + 6144 + 2048, xws, 0});
  xcd_barrier(xb);
#if STOP_AFTER == 18
  zfill(p.out, O_Y, O_CONVP);
  return;
#endif
#pragma unroll 1
  for (int rep = 0; rep < REP_ELT; ++rep)
    phase_adaln(p, 1, 1, false);
  xcd_barrier(xb);
#if STOP_AFTER == 19
  zfill(p.out, O_Y, O_CONVP);
  return;
#endif
#pragma unroll 1
  for (int rep = 0; rep < REP_GEMM; ++rep)
  gemm_phase(hm, (const bf16_t*)(ws + W_Q_T) + (size_t)2048 * 1024, NTOK, 2048, 1024, lds, EpiBf{(bf16_t*)(ws + W_ORAW), 2048});
  xcd_barrier(xb);
#if STOP_AFTER == 20
  zfill(p.out, O_Y, O_CONVP);
  return;
#endif
#pragma unroll 1
  for (int rep = 0; rep < REP_TOPK; ++rep) phase_topk(p, 1, lds);
  xcd_barrier(xb);
#if STOP_AFTER == 21
  zfill(p.out, O_Y, O_CONVP);
  return;
#endif
  phase_gather(p, 1, lds);
}

extern "C" void kernel_launch(void* const* d_in, const int* in_sizes, int n_in, void* d_out, int out_size, void* d_ws, size_t ws_size, hipStream_t stream) {
  static int grid_blocks = 0;
  if (grid_blocks == 0) {
    if (n_in != 31 || ws_size < W_END) { fprintf(stderr, "kernel_launch: need 31 inputs and %zu bytes of ws; got %d, %zu\n", (size_t)W_END, n_in, ws_size); grid_blocks = -1; return; }
    int dev = 0, cus = 0, per_cu = 0;
    (void)hipGetDevice(&dev);
    (void)hipDeviceGetAttribute(&cus, hipDeviceAttributeMultiprocessorCount, dev);
    (void)hipOccupancyMaxActiveBlocksPerMultiprocessor(&per_cu, mega, NTHR, 0);
    if (per_cu < 1) { fprintf(stderr, "kernel_launch: occupancy query returned %d\n", per_cu); grid_blocks = -1; return; }
    if (per_cu > 2) per_cu = 2;
    grid_blocks = cus * per_cu;
  }
  if (grid_blocks < 0) return;
  if (hipMemsetAsync((char*)d_ws + W_BAR, 0, XCD_BAR_WORDS * 4, stream) != hipSuccess) { fprintf(stderr, "kernel_launch: memset of barrier words failed\n"); return; }
  Params p{};
  const float** pf = (const float**)&p;
  for (int i = 0; i < 31; ++i) pf[i] = (const float*)d_in[i];
  p.out = (float*)d_out; p.ws = (char*)d_ws;
  void* args[] = {&p};
  hipError_t e = hipLaunchCooperativeKernel((void*)mega, dim3(grid_blocks), dim3(NTHR), args, 0, stream);
  if (e != hipSuccess) fprintf(stderr, "cooperative launch failed: %s (grid %d)\n", hipGetErrorString(e), grid_blocks);
}
```

```cpp
#include <hip/hip_runtime.h>
#include <hip/hip_cooperative_groups.h>
#include <cstdio>
#include <cstdint>
namespace cg = cooperative_groups;
#define STOP_AFTER 0
#define REP_GEMM 1
#define DBG_NCH 32
#ifndef REP_SCAN
#define REP_SCAN 1
#endif
#ifndef REP_PREP
#define REP_PREP 1
#endif
#ifndef REP_P0
#define REP_P0 1
#endif
#ifndef REP_SYNC
#define REP_SYNC 0
#endif
#ifndef REP_ELT
#define REP_ELT 1
#endif
#ifndef REP_GEMM
#define REP_GEMM 1
#endif
#ifndef REP_TOPK
#define REP_TOPK 1
#endif
#ifndef REP_GATHER
#define REP_GATHER 1
#endif

typedef unsigned short bf16_t;
typedef short bf16x8 __attribute__((ext_vector_type(8)));
typedef float f32x4 __attribute__((ext_vector_type(4)));
#define LDS_AS __attribute__((address_space(3)))

constexpr int D = 1024, NTOK = 16512, NPT = 16384, SEQ = 2048, NSEQ = 136;
constexpr int AB_IN = 6688, AB_IN_PAD = 6784, CONV_CH = 4608, GZ_W = 2080, RET_IN = 6144;
constexpr int NTHR = 256;
constexpr float U_SCALE = 256.f, V_SCALE = 16.f;
constexpr int LDS_BYTES = 77824;

constexpr size_t O_Y = 0, O_CONVP = 16908288, O_GDNP = 17018880, O_SSMP = 18067456, O_RETP = 19116032,
                 O_CONVS = 23310336, O_GDNS = 25079808, O_SSMS = 41857024, O_RETS = 58634240;

constexpr size_t al256(size_t x) { return (x + 255) & ~(size_t)255; }
constexpr size_t W_ADA_T = 0;
constexpr size_t W_IN0_T = W_ADA_T + al256((size_t)12288 * 1024 * 2);
constexpr size_t W_OUT0_T = W_IN0_T + al256((size_t)AB_IN_PAD * 1024 * 2);
constexpr size_t W_IN1_T = W_OUT0_T + al256((size_t)1024 * 2048 * 2);
constexpr size_t W_OUT1_T = W_IN1_T + al256((size_t)6144 * 1024 * 2);
constexpr size_t W_Q_T = W_OUT1_T + al256((size_t)1024 * 2048 * 2);
constexpr size_t W_KEYS = W_Q_T + al256((size_t)2 * 2048 * 1024 * 2);
constexpr size_t W_U = W_KEYS + al256((size_t)2 * 2 * 128 * 128 * 2);
constexpr size_t W_V = W_U + al256((size_t)2 * 16384 * 1024 * 2);
constexpr size_t W_SILUC = W_V + al256((size_t)2 * 16384 * 1024 * 2);
constexpr size_t W_MOD = W_SILUC + al256((size_t)256 * 1024 * 2);
constexpr size_t W_X = W_MOD + al256((size_t)NSEQ * 12288 * 4);
constexpr size_t W_HM = W_X + al256((size_t)NTOK * 1024 * 4);
constexpr size_t W_SCAL = W_HM + al256((size_t)NTOK * 1024 * 2);
constexpr size_t W_GZ = W_SCAL + al256((size_t)NTOK * 48 * 4);
constexpr size_t W_XBC = W_GZ + al256((size_t)NTOK * GZ_W * 2);
constexpr size_t W_ORAW = W_XBC + al256((size_t)NTOK * CONV_CH * 2);
constexpr size_t W_A2 = W_ORAW + al256((size_t)NTOK * 2048 * 2);
constexpr size_t W_TKI = W_A2 + al256((size_t)NTOK * 2048 * 2);
constexpr size_t W_TKG = W_TKI + al256((size_t)NTOK * 128 * 4);
constexpr size_t W_DEC = W_TKG + al256((size_t)NTOK * 128 * 4);
constexpr size_t W_BAR = W_DEC + al256((size_t)8192 * 4);
constexpr size_t W_BIG = W_BAR + al256((size_t)4096 * 4);
constexpr size_t GDN_BLOB = 73728, SSD_BLOB = 40960, RET_BLOB = 73728;
constexpr size_t W_PRE = W_BIG;
constexpr size_t W_GDNB = W_BIG;
constexpr size_t W_SSDB = W_GDNB + al256(2048 * GDN_BLOB);
constexpr size_t W_PROJ1 = W_BIG;
constexpr size_t W_RETB = W_PROJ1 + al256((size_t)NTOK * RET_IN * 2);
constexpr size_t W_END0 = W_SSDB + al256(4096 * SSD_BLOB);
constexpr size_t W_END1 = W_RETB + al256(1024 * RET_BLOB);
constexpr size_t W_END = W_END0 > W_END1 ? W_END0 : W_END1;

struct Params {
  const float *x_prompt, *x_sample, *c_prompt, *c_sample, *state_conv, *state_gdn, *state_ssm, *state_ret;
  const float *ada_w, *ada_b, *norm1_g, *norm2_g, *ab_w_in, *ab_conv_w, *ab_conv_b, *gdn_a_log, *gdn_dt_bias, *gdn_norm_g;
  const float *ssm_a_log, *ssm_dt_bias, *ssm_d, *ssm_norm_g, *ab_w_out, *ret_w_in, *ret_norm_g, *ret_w_out;
  const float *peer_w_q, *peer_keys, *peer_u, *peer_v, *final_g;
  float* out;
  char* ws;
};

__device__ __forceinline__ int tidx() { int t = threadIdx.x; asm volatile("" : "+v"(t)); return t; }
typedef __bf16 bf16x2_t __attribute__((ext_vector_type(2)));
typedef float f32x2_t __attribute__((ext_vector_type(2)));
__device__ __forceinline__ unsigned pk2(float lo, float hi) { f32x2_t v = {lo, hi}; bf16x2_t b = __builtin_convertvector(v, bf16x2_t); return __builtin_bit_cast(unsigned, b); }
__device__ __forceinline__ float bf_lo(unsigned u) { return __uint_as_float(u << 16); }
__device__ __forceinline__ float bf_hi(unsigned u) { return __uint_as_float(u & 0xffff0000u); }
__device__ __forceinline__ float bf2f(bf16_t h) { return __uint_as_float(((unsigned)h) << 16); }
__device__ __forceinline__ bf16_t f2bf(float f) { return (bf16_t)(pk2(f, 0.f) & 0xffffu); }
__device__ __forceinline__ void unpack8(uint4 v, float* f) {
  f[0] = bf_lo(v.x); f[1] = bf_hi(v.x); f[2] = bf_lo(v.y); f[3] = bf_hi(v.y);
  f[4] = bf_lo(v.z); f[5] = bf_hi(v.z); f[6] = bf_lo(v.w); f[7] = bf_hi(v.w);
}
__device__ __forceinline__ uint4 pack8(const float* f) { return make_uint4(pk2(f[0], f[1]), pk2(f[2], f[3]), pk2(f[4], f[5]), pk2(f[6], f[7])); }
__device__ __forceinline__ void load8f(const float* p, float* f) {
  float4 a = *(const float4*)p, b = *(const float4*)(p + 4);
  f[0] = a.x; f[1] = a.y; f[2] = a.z; f[3] = a.w; f[4] = b.x; f[5] = b.y; f[6] = b.z; f[7] = b.w;
}
__device__ __forceinline__ void store8f(float* p, const float* f) {
  *(float4*)p = make_float4(f[0], f[1], f[2], f[3]); *(float4*)(p + 4) = make_float4(f[4], f[5], f[6], f[7]);
}
__device__ __forceinline__ float wave_sum(float v) {
#pragma unroll
  for (int o = 1; o < 64; o <<= 1) v += __shfl_xor(v, o);
  return v;
}
__device__ __forceinline__ float dpp_add(float v, const int ctrl_sel) {
  int iv = __float_as_int(v), r;
  if (ctrl_sel == 0) r = __builtin_amdgcn_update_dpp(iv, iv, 0xB1, 0xF, 0xF, false);
  else if (ctrl_sel == 1) r = __builtin_amdgcn_update_dpp(iv, iv, 0x4E, 0xF, 0xF, false);
  else if (ctrl_sel == 2) r = __builtin_amdgcn_update_dpp(iv, iv, 0x141, 0xF, 0xF, false);
  else r = __builtin_amdgcn_update_dpp(iv, iv, 0x140, 0xF, 0xF, false);
  return v + __int_as_float(r);
}
__device__ __forceinline__ float wave_sum_fast(float v) {
  v = dpp_add(v, 0); v = dpp_add(v, 1); v = dpp_add(v, 2); v = dpp_add(v, 3);
  const int iv = __float_as_int(v);
  return (__int_as_float(__builtin_amdgcn_readlane(iv, 0)) + __int_as_float(__builtin_amdgcn_readlane(iv, 16))) +
         (__int_as_float(__builtin_amdgcn_readlane(iv, 32)) + __int_as_float(__builtin_amdgcn_readlane(iv, 48)));
}
__device__ __forceinline__ float grp16_sum(float v) {
#pragma unroll
  for (int o = 1; o < 16; o <<= 1) v += __shfl_xor(v, o);
  return v;
}
__device__ __forceinline__ float sigmoidf_(float x) { return 1.f / (1.f + __expf(-x)); }
__device__ __forceinline__ float siluf_(float x) { return x / (1.f + __expf(-x)); }
__device__ __forceinline__ float softplusf_(float x) { return fmaxf(x, 0.f) + log1pf(__expf(-fabsf(x))); }
__device__ __forceinline__ float geluf_(float x) { return 0.5f * x * (1.f + erff(x * 0.70710678118654752f)); }
__device__ __forceinline__ int seq_row(int t) { return t < NPT ? (t >> 11) : (8 + t - NPT); }
__device__ __forceinline__ const float* xin_row(const Params& p, int t) { return t < NPT ? p.x_prompt + (size_t)t * D : p.x_sample + (size_t)(t - NPT) * D; }
__device__ __forceinline__ bf16x8 ld16(const bf16_t* p) { return *(const bf16x8*)p; }
__device__ __forceinline__ float4 ldnt4(const float* p) { f32x4 v = __builtin_nontemporal_load((const f32x4*)p); return make_float4(v[0], v[1], v[2], v[3]); }
typedef unsigned u32x4_t __attribute__((ext_vector_type(4)));
__device__ __forceinline__ uint4 ldnt_u4(const void* p) { u32x4_t v = __builtin_nontemporal_load((const u32x4_t*)p); return make_uint4(v[0], v[1], v[2], v[3]); }
__device__ __forceinline__ void stnt4(float* p, float4 v) { f32x4 w = {v.x, v.y, v.z, v.w}; __builtin_nontemporal_store(w, (f32x4*)p); }
__device__ __forceinline__ f32x4 mfma16(bf16x8 a, bf16x8 b, f32x4 c) { return __builtin_amdgcn_mfma_f32_16x16x32_bf16(a, b, c, 0, 0, 0); }

__device__ __forceinline__ void transpose_item(const float* W, int K, int N, int Npad, bf16_t* WT, int item, float* tile) {
  const int nb = Npad / 64; const int kb = item / nb, nbi = item % nb; const int k0 = kb * 64, n0 = nbi * 64;
  const int tid = tidx();
#pragma unroll
  for (int i = 0; i < 16; ++i) {
    int kk = i * 4 + (tid >> 6), nn = tid & 63; int n = n0 + nn;
    tile[kk * 65 + nn] = (n < N) ? __builtin_nontemporal_load(W + (size_t)(k0 + kk) * N + n) : 0.f;
  }
  __syncthreads();
  {
    int n = tid >> 2, kc = (tid & 3) * 16;
    unsigned o[8];
#pragma unroll
    for (int j = 0; j < 8; ++j) o[j] = pk2(tile[(kc + 2 * j) * 65 + n], tile[(kc + 2 * j + 1) * 65 + n]);
    uint4* dst = (uint4*)(WT + (size_t)(n0 + n) * K + k0 + kc);
    dst[0] = make_uint4(o[0], o[1], o[2], o[3]); dst[1] = make_uint4(o[4], o[5], o[6], o[7]);
  }
  __syncthreads();
}
__device__ __forceinline__ void cvt_stream(const float* src, bf16_t* dst, size_t n8, size_t gtid, size_t gsz) {
  for (size_t i = gtid; i < n8; i += gsz) { float f[8]; load8f(src + i * 8, f); *(uint4*)(dst + i * 8) = pack8(f); }
}
__device__ __forceinline__ void cvt_stream_fp8(const float* src, unsigned char* dst, size_t n16, float scale, size_t gtid, size_t gsz) {
  const size_t n4 = n16 * 4;
  size_t i = gtid;
  for (; i + 3 * gsz < n4; i += 4 * gsz) {
    float4 f[4];
#pragma unroll
    for (int q = 0; q < 4; ++q) f[q] = ldnt4(src + (i + q * gsz) * 4);
#pragma unroll
    for (int q = 0; q < 4; ++q) {
      int v = __builtin_amdgcn_cvt_pk_fp8_f32(f[q].x * scale, f[q].y * scale, 0, false);
      v = __builtin_amdgcn_cvt_pk_fp8_f32(f[q].z * scale, f[q].w * scale, v, true);
      *(unsigned*)(dst + (i + q * gsz) * 4) = (unsigned)v;
    }
  }
  for (; i < n4; i += gsz) {
    float4 f = ldnt4(src + i * 4);
    int v = __builtin_amdgcn_cvt_pk_fp8_f32(f.x * scale, f.y * scale, 0, false);
    v = __builtin_amdgcn_cvt_pk_fp8_f32(f.z * scale, f.w * scale, v, true);
    *(unsigned*)(dst + i * 4) = (unsigned)v;
  }
}
__device__ __forceinline__ void phase_prep(const Params& p, char* lds) {
  float* tile = (float*)lds;
  char* ws = p.ws;
  const int I_ADA = 16 * 96, I_IN0 = 16 * 106, I_OUT = 32 * 16, I_IN1 = 16 * 96, I_Q = 16 * 32;
  const int NIT = 2 * I_ADA + I_IN0 + I_OUT + I_IN1 + I_OUT + 2 * I_Q;
  for (int it = blockIdx.x; it < NIT; it += gridDim.x) {
    int r = it;
    if (r < I_ADA) { transpose_item(p.ada_w, 1024, 6144, 6144, (bf16_t*)(ws + W_ADA_T), r, tile); continue; } r -= I_ADA;
    if (r < I_ADA) { transpose_item(p.ada_w + (size_t)1024 * 6144, 1024, 6144, 6144, (bf16_t*)(ws + W_ADA_T) + (size_t)6144 * 1024, r, tile); continue; } r -= I_ADA;
    if (r < I_IN0) { transpose_item(p.ab_w_in, 1024, AB_IN, AB_IN_PAD, (bf16_t*)(ws + W_IN0_T), r, tile); continue; } r -= I_IN0;
    if (r < I_OUT) { transpose_item(p.ab_w_out, 2048, 1024, 1024, (bf16_t*)(ws + W_OUT0_T), r, tile); continue; } r -= I_OUT;
    if (r < I_IN1) { transpose_item(p.ret_w_in, 1024, 6144, 6144, (bf16_t*)(ws + W_IN1_T), r, tile); continue; } r -= I_IN1;
    if (r < I_OUT) { transpose_item(p.ret_w_out, 2048, 1024, 1024, (bf16_t*)(ws + W_OUT1_T), r, tile); continue; } r -= I_OUT;
    if (r < I_Q) { transpose_item(p.peer_w_q, 1024, 2048, 2048, (bf16_t*)(ws + W_Q_T), r, tile); continue; } r -= I_Q;
    transpose_item(p.peer_w_q + (size_t)1024 * 2048, 1024, 2048, 2048, (bf16_t*)(ws + W_Q_T) + (size_t)2048 * 1024, r, tile);
  }
  const size_t gtid = (size_t)blockIdx.x * NTHR + tidx(), gsz = (size_t)gridDim.x * NTHR;
  cvt_stream_fp8(p.peer_u, (unsigned char*)(ws + W_U), (size_t)2 * 16384 * 1024 / 16, U_SCALE, gtid, gsz);
  cvt_stream_fp8(p.peer_v, (unsigned char*)(ws + W_V), (size_t)2 * 16384 * 1024 / 16, V_SCALE, gtid, gsz);
  cvt_stream(p.peer_keys, (bf16_t*)(ws + W_KEYS), (size_t)2 * 2 * 128 * 128 / 8, gtid, gsz);
  bf16_t* sc = (bf16_t*)(ws + W_SILUC);
  for (size_t i = gtid; i < (size_t)256 * 1024 / 8; i += gsz) {
    int r = (int)(i >> 7), c8 = (int)(i & 127) * 8;
    float f[8];
    if (r < NSEQ) {
      const float* src = (r < 8) ? p.c_prompt + (size_t)r * D + c8 : p.c_sample + (size_t)(r - 8) * D + c8;
      load8f(src, f);
#pragma unroll
      for (int j = 0; j < 8; ++j) f[j] = siluf_(f[j]);
    } else {
#pragma unroll
      for (int j = 0; j < 8; ++j) f[j] = 0.f;
    }
    *(uint4*)(sc + i * 8) = pack8(f);
  }
}

template <class Epi>
__device__ __forceinline__ void gemm_phase(const bf16_t* __restrict__ A, const bf16_t* __restrict__ Bt, int M, int N, int K, char* lds, Epi epi) {
  const int nM = (M + 127) / 128, nN = (N + 127) / 128;
  const int tid = tidx(), lane = tid & 63, wave = tid >> 6, wr = wave >> 1, wc = wave & 1, fr = lane & 15, fq = lane >> 4;
  char* As = lds; char* Bs = lds + 16384;
  const int sc = tid & 7, sr = tid >> 3;
  for (int tile = blockIdx.x; tile < nM * nN; tile += gridDim.x) {
    const int tm = tile / nN, tn = tile % nN; const int m0 = tm * 128, n0 = tn * 128;
    f32x4 acc[4][4];
#pragma unroll
    for (int m = 0; m < 4; ++m)
#pragma unroll
      for (int n = 0; n < 4; ++n) acc[m][n] = (f32x4){0.f, 0.f, 0.f, 0.f};
    const bf16_t* Ap = A + (size_t)(m0 + sr) * K + sc * 8;
    const bf16_t* Bp = Bt + (size_t)(n0 + sr) * K + sc * 8;
    const size_t K32 = (size_t)32 * K;
    uint4 ra0 = *(const uint4*)(Ap), ra1 = *(const uint4*)(Ap + K32), ra2 = *(const uint4*)(Ap + 2 * K32), ra3 = *(const uint4*)(Ap + 3 * K32);
    uint4 rb0 = *(const uint4*)(Bp), rb1 = *(const uint4*)(Bp + K32), rb2 = *(const uint4*)(Bp + 2 * K32), rb3 = *(const uint4*)(Bp + 3 * K32);
    const int off0 = sr * 128 + ((sc ^ (sr & 7)) << 4);
    for (int k0 = 0; k0 < K; k0 += 64) {
      __syncthreads();
      *(uint4*)(As + off0) = ra0; *(uint4*)(As + off0 + 4096) = ra1; *(uint4*)(As + off0 + 8192) = ra2; *(uint4*)(As + off0 + 12288) = ra3;
      *(uint4*)(Bs + off0) = rb0; *(uint4*)(Bs + off0 + 4096) = rb1; *(uint4*)(Bs + off0 + 8192) = rb2; *(uint4*)(Bs + off0 + 12288) = rb3;
      __syncthreads();
      {
        const int kn = (k0 + 64 < K) ? k0 + 64 : k0;
        ra0 = *(const uint4*)(Ap + kn); ra1 = *(const uint4*)(Ap + K32 + kn); ra2 = *(const uint4*)(Ap + 2 * K32 + kn); ra3 = *(const uint4*)(Ap + 3 * K32 + kn);
        rb0 = *(const uint4*)(Bp + kn); rb1 = *(const uint4*)(Bp + K32 + kn); rb2 = *(const uint4*)(Bp + 2 * K32 + kn); rb3 = *(const uint4*)(Bp + 3 * K32 + kn);
      }
#pragma unroll
      for (int kk = 0; kk < 2; ++kk) {
        bf16x8 af[4], bfv[4];
#pragma unroll
        for (int m = 0; m < 4; ++m) { int row = wr * 64 + m * 16 + fr; af[m] = *(const bf16x8*)(As + row * 128 + (((kk * 4 + fq) ^ (row & 7)) << 4)); }
#pragma unroll
        for (int n = 0; n < 4; ++n) { int row = wc * 64 + n * 16 + fr; bfv[n] = *(const bf16x8*)(Bs + row * 128 + (((kk * 4 + fq) ^ (row & 7)) << 4)); }
        __builtin_amdgcn_s_setprio(1);
#pragma unroll
        for (int m = 0; m < 4; ++m)
#pragma unroll
          for (int n = 0; n < 4; ++n) acc[m][n] = mfma16(bfv[n], af[m], acc[m][n]);
        __builtin_amdgcn_s_setprio(0);
      }
    }
#pragma unroll
    for (int m = 0; m < 4; ++m)
#pragma unroll
      for (int n = 0; n < 4; ++n) epi(m0 + wr * 64 + m * 16 + fr, n0 + wc * 64 + n * 16 + fq * 4, acc[m][n]);
  }
}

struct EpiMod { float* mod; const float* bias;
  __device__ __forceinline__ void operator()(int r, int c, f32x4 v) const {
    if (r < NSEQ) { float4 b = *(const float4*)(bias + c); *(float4*)(mod + (size_t)r * 12288 + c) = make_float4(v[0] + b.x, v[1] + b.y, v[2] + b.z, v[3] + b.w); } } };
struct EpiProj0 { bf16_t* pre; bf16_t* gz;
  __device__ __forceinline__ void operator()(int r, int c, f32x4 v) const {
    uint2 o = make_uint2(pk2(v[0], v[1]), pk2(v[2], v[3]));
    if (c < CONV_CH) *(uint2*)(pre + (size_t)r * CONV_CH + c) = o;
    else if (c < AB_IN) *(uint2*)(gz + (size_t)r * GZ_W + (c - CONV_CH)) = o; } };
struct EpiBf { bf16_t* dst; int ld;
  __device__ __forceinline__ void operator()(int r, int c, f32x4 v) const { *(uint2*)(dst + (size_t)r * ld + c) = make_uint2(pk2(v[0], v[1]), pk2(v[2], v[3])); } };
struct EpiRes { const float* xp; const float* xs; const float* gate;   float* xws; int from_input;
  __device__ __forceinline__ void operator()(int r, int c, f32x4 v) const {
    const float* xr = from_input ? (r < NPT ? xp + (size_t)r * D : xs + (size_t)(r - NPT) * D) : xws + (size_t)r * D;
    float4 x = *(const float4*)(xr + c); float4 g = *(const float4*)(gate + (size_t)seq_row(r) * 12288 + c);
    *(float4*)(xws + (size_t)r * D + c) = make_float4(x.x + g.x * v[0], x.y + g.y * v[1], x.z + g.z * v[2], x.w + g.w * v[3]); } };

__device__ __forceinline__ void adaln_write(const float* xv  , float ss, const float* g, const float* sc, const float* sh, bf16_t* orow, int lane) {
  const float rstd = rsqrtf(ss * (1.f / D) + 1e-6f);
#pragma unroll
  for (int j = 0; j < 2; ++j) {
    const int c = j * 512 + lane * 8;
    float gg[8], s1[8], s2[8], o[8];
    load8f(g + c, gg); load8f(sc + c, s1); load8f(sh + c, s2);
#pragma unroll
    for (int i = 0; i < 8; ++i) o[i] = xv[j * 8 + i] * rstd * gg[i] * (1.f + s1[i]) + s2[i];
    *(uint4*)(orow + c) = pack8(o);
  }
}
__device__ __forceinline__ void phase_adaln(const Params& p, int layer, int which, bool from_input) {
  const int lane = tidx() & 63, wave = tidx() >> 6;
  const float* mod = (const float*)(p.ws + W_MOD);
  bf16_t* hm = (bf16_t*)(p.ws + W_HM);
  const float* xws = (const float*)(p.ws + W_X);
  const float* g = (which == 0 ? p.norm1_g : p.norm2_g) + layer * D;
  for (int t = blockIdx.x * 4 + wave; t < NTOK; t += gridDim.x * 4) {
    const float* xr = from_input ? xin_row(p, t) : xws + (size_t)t * D;
    float xv[16]; load8f(xr + lane * 8, xv); load8f(xr + 512 + lane * 8, xv + 8);
    float ss = 0.f;
#pragma unroll
    for (int i = 0; i < 16; ++i) ss += xv[i] * xv[i];
    ss = wave_sum(ss);
    const float* mr = mod + (size_t)seq_row(t) * 12288 + layer * 6144 + which * 3072;
    adaln_write(xv, ss, g, mr + 1024, mr, hm + (size_t)t * D, lane);
  }
}

__device__ __forceinline__ void phase_conv(const Params& p) {
  const int lane = tidx() & 63, wave = tidx() >> 6;
  const bf16_t* pre = (const bf16_t*)(p.ws + W_PRE);
  const bf16_t* gz = (const bf16_t*)(p.ws + W_GZ);
  bf16_t* xbc = (bf16_t*)(p.ws + W_XBC);
  float* scal = (float*)(p.ws + W_SCAL);
  for (int t = blockIdx.x * 4 + wave; t < NTOK; t += gridDim.x * 4) {
    const bool smp = t >= NPT; const int b = smp ? t - NPT : (t >> 11); const int l = smp ? 0 : (t & 2047);
#pragma unroll 3
    for (int ch = 0; ch < 9; ++ch) {
      const int c = ch * 512 + lane * 8;
      float cur[8], p1[8], p2[8], p3[8];
      unpack8(*(const uint4*)(pre + (size_t)t * CONV_CH + c), cur);
      if (smp) {
        const float* st = p.state_conv + (size_t)b * 3 * CONV_CH + c;
        load8f(st + 2 * CONV_CH, p1); load8f(st + CONV_CH, p2); load8f(st, p3);
      } else {
        if (l >= 1) unpack8(*(const uint4*)(pre + (size_t)(t - 1) * CONV_CH + c), p1); else { for (int i = 0; i < 8; ++i) p1[i] = 0.f; }
        if (l >= 2) unpack8(*(const uint4*)(pre + (size_t)(t - 2) * CONV_CH + c), p2); else { for (int i = 0; i < 8; ++i) p2[i] = 0.f; }
        if (l >= 3) unpack8(*(const uint4*)(pre + (size_t)(t - 3) * CONV_CH + c), p3); else { for (int i = 0; i < 8; ++i) p3[i] = 0.f; }
      }
      float w0[8], w1[8], w2[8], w3[8], bb[8], y[8];
      load8f(p.ab_conv_w + c, w0); load8f(p.ab_conv_w + CONV_CH + c, w1); load8f(p.ab_conv_w + 2 * CONV_CH + c, w2); load8f(p.ab_conv_w + 3 * CONV_CH + c, w3);
      load8f(p.ab_conv_b + c, bb);
      float ss = 0.f;
#pragma unroll
      for (int i = 0; i < 8; ++i) { float v = bb[i] + w3[i] * cur[i] + w2[i] * p1[i] + w1[i] * p2[i] + w0[i] * p3[i]; v = siluf_(v); y[i] = v; ss += v * v; }
      if (ch < 4) {
        ss = grp16_sum(ss);
        float s = rsqrtf(ss + 1e-6f) * (ch < 2 ? 0.08838834764831845f : 1.f);
#pragma unroll
        for (int i = 0; i < 8; ++i) y[i] *= s;
      }
      *(uint4*)(xbc + (size_t)t * CONV_CH + c) = pack8(y);
      if (smp) {
        float* o = p.out + O_CONVS + (size_t)b * 3 * CONV_CH + c;
        store8f(o, p2); store8f(o + CONV_CH, p1); store8f(o + 2 * CONV_CH, cur);
      } else if (l >= SEQ - 3) {
        store8f(p.out + O_CONVP + ((size_t)b * 3 + (l - (SEQ - 3))) * CONV_CH + c, cur);
      }
    }
    if (lane < 32) {
      const bf16_t* gr = gz + (size_t)t * GZ_W + 2048;
      float v;
      if (lane < 8) { v = sigmoidf_(bf2f(gr[lane])); }
      else if (lane < 16) { int h = lane - 8; v = -__expf(p.gdn_a_log[h]) * softplusf_(bf2f(gr[8 + h]) + p.gdn_dt_bias[h]); }
      else { int h = lane - 16; v = softplusf_(bf2f(gr[16 + h]) + p.ssm_dt_bias[h]); }
      scal[(size_t)t * 48 + lane] = v;
      if (lane >= 16) { int h = lane - 16; scal[(size_t)t * 48 + 32 + h] = -v * __expf(p.ssm_a_log[h]); }
    }
  }
}

template <int DK>
__device__ __forceinline__ void qk_blobs(const bf16_t* qS, const bf16_t* kS, const float* gcS, const float* jsS, const float* betaS,
                                         bf16_t* Qg, bf16_t* KdT, bf16_t* QKd, float* Lout) {
  constexpr int LD = DK + 8, KS = DK / 32;
  const int tid = tidx(), lane = tid & 63, w = tid >> 6, fr = lane & 15, fq = lane >> 4;
  const int i = 16 * w + fr; const float gci = gcS[i];
#pragma unroll
  for (int nt = 0; nt < 4; ++nt) {
    f32x4 acc = (f32x4){0.f, 0.f, 0.f, 0.f}, acc2 = (f32x4){0.f, 0.f, 0.f, 0.f};
#pragma unroll
    for (int ks = 0; ks < KS; ++ks) {
      bf16x8 a = *(const bf16x8*)(kS + (nt * 16 + fr) * LD + ks * 32 + fq * 8);
      bf16x8 bq = *(const bf16x8*)(qS + i * LD + ks * 32 + fq * 8);
      acc = mfma16(a, bq, acc);
      if (Lout) { bf16x8 bk = *(const bf16x8*)(kS + i * LD + ks * 32 + fq * 8); acc2 = mfma16(a, bk, acc2); }
    }
    float o[4], lo[4];
#pragma unroll
    for (int jj = 0; jj < 4; ++jj) {
      const int j = nt * 16 + fq * 4 + jj;
      const float dcy = (j <= i) ? __expf(gci - gcS[j]) : 0.f;
      o[jj] = (j <= i) ? acc[jj] * dcy * jsS[j] : 0.f;
      lo[jj] = (j < i) ? acc2[jj] * dcy * betaS[i] : 0.f;
    }
    *(uint2*)(QKd + i * 64 + nt * 16 + fq * 4) = make_uint2(pk2(o[0], o[1]), pk2(o[2], o[3]));
    if (Lout) *(float4*)(Lout + i * 68 + nt * 16 + fq * 4) = make_float4(lo[0], lo[1], lo[2], lo[3]);
  }
  for (int idx = tid; idx < 64 * (DK / 8); idx += NTHR) {
    const int r = idx / (DK / 8), c8 = idx % (DK / 8);
    float f[8]; unpack8(*(const uint4*)(qS + r * LD + c8 * 8), f);
    const float s = __expf(gcS[r]);
#pragma unroll
    for (int q = 0; q < 8; ++q) f[q] *= s;
    *(uint4*)(Qg + r * DK + c8 * 8) = pack8(f);
  }
  const float glast = gcS[63];
  for (int idx = tid; idx < DK * 8; idx += NTHR) {
    const int d = idx >> 3, j0 = (idx & 7) * 8;
    float f[8];
#pragma unroll
    for (int q = 0; q < 8; ++q) f[q] = bf2f(kS[(j0 + q) * LD + d]) * jsS[j0 + q] * __expf(glast - gcS[j0 + q]);
    *(uint4*)(KdT + d * 64 + j0) = pack8(f);
  }
}

__device__ __forceinline__ float wave_incl_scan(float v, int lane) {
#pragma unroll
  for (int o = 1; o < 64; o <<= 1) { float u = __shfl_up(v, o); if (lane >= o) v += u; }
  return v;
}

__device__ __forceinline__ void gdn_prep_item(const Params& p, int it, char* lds) {
  constexpr int LD = 136;
  bf16_t* qS = (bf16_t*)lds; bf16_t* kS = qS + 64 * LD; float* L = (float*)(kS + 64 * LD);
  float* gcS = L + 64 * 68; float* jsS = gcS + 64; float* betaS = jsS + 64;
  const int tid = tidx(), lane = tid & 63;
  const int bh = it >> 5, c = it & 31, b = bh >> 3, h = bh & 7; const int t0 = b * SEQ + c * 64;
  const bf16_t* xbc = (const bf16_t*)(p.ws + W_XBC);
  const float* scal = (const float*)(p.ws + W_SCAL);
  char* blob = p.ws + W_GDNB + (size_t)it * GDN_BLOB;
  bf16_t* Qg = (bf16_t*)blob; bf16_t* KdT = Qg + 64 * 128; bf16_t* QKd = KdT + 128 * 64; bf16_t* Wn = QKd + 4096; bf16_t* U0 = Wn + 64 * 128;
  for (int idx = tid; idx < 64 * 16; idx += NTHR) {
    const int r = idx >> 4, c8 = (idx & 15) * 8;
    *(uint4*)(qS + r * LD + c8) = *(const uint4*)(xbc + (size_t)(t0 + r) * CONV_CH + h * 128 + c8);
    *(uint4*)(kS + r * LD + c8) = *(const uint4*)(xbc + (size_t)(t0 + r) * CONV_CH + 1024 + h * 128 + c8);
  }
  if (tid < 64) {
    float g = scal[(size_t)(t0 + tid) * 48 + 8 + h];
    float gc = wave_incl_scan(g, lane);
    gcS[tid] = gc; jsS[tid] = 1.f; betaS[tid] = scal[(size_t)(t0 + tid) * 48 + h];
    if (tid == 63) ((float*)(p.ws + W_DEC))[it] = __expf(gc);
  }
  __syncthreads();
  qk_blobs<128>(qS, kS, gcS, jsS, betaS, Qg, KdT, QKd, L);
  __syncthreads();
  float x[64];
  if (tid < 128) {
#pragma unroll
    for (int i = 0; i < 64; ++i) x[i] = bf2f(xbc[(size_t)(t0 + i) * CONV_CH + 2048 + h * 128 + tid]) * betaS[i];
  } else {
#pragma unroll
    for (int i = 0; i < 64; ++i) x[i] = bf2f(kS[i * LD + (tid - 128)]) * betaS[i] * __expf(gcS[i]);
  }
#pragma unroll
  for (int i = 1; i < 64; ++i) {
    float s = x[i];
#pragma unroll
    for (int j4 = 0; j4 < (i + 3) / 4; ++j4) {
      float4 l = *(const float4*)(L + i * 68 + j4 * 4);
      if (j4 * 4 + 0 < i) s -= l.x * x[j4 * 4 + 0];
      if (j4 * 4 + 1 < i) s -= l.y * x[j4 * 4 + 1];
      if (j4 * 4 + 2 < i) s -= l.z * x[j4 * 4 + 2];
      if (j4 * 4 + 3 < i) s -= l.w * x[j4 * 4 + 3];
    }
    x[i] = s;
  }
  if (tid < 128) {
#pragma unroll
    for (int i = 0; i < 64; ++i) U0[i * 128 + tid] = f2bf(x[i]);
  } else {
#pragma unroll
    for (int i = 0; i < 64; ++i) Wn[i * 128 + (tid - 128)] = f2bf(-x[i]);
  }
  __syncthreads();
#ifdef CHK_PREP
  { __threadfence(); unsigned xx = 0; const unsigned* wp = (const unsigned*)blob;
    for (int i = tid; i < (int)GDN_BLOB / 4; i += NTHR) xx ^= wp[i];
    p.out[O_GDNP + (size_t)it * 512 + tid] = (float)(xx & 0xFFFF); p.out[O_GDNP + (size_t)it * 512 + 256 + tid] = (float)(xx >> 16); }
#endif
}

__device__ __forceinline__ void ssd_prep_item(const Params& p, int it, char* lds) {
  constexpr int LD = 136;
  bf16_t* qS = (bf16_t*)lds; bf16_t* kS = qS + 64 * LD; float* gcS = (float*)(kS + 64 * LD); float* jsS = gcS + 64; float* betaS = jsS + 64;
  const int tid = tidx(), lane = tid & 63;
  const int bh = it >> 5, c = it & 31, b = bh >> 4, h = bh & 15, g = h >> 3; const int t0 = b * SEQ + c * 64;
  const bf16_t* xbc = (const bf16_t*)(p.ws + W_XBC);
  const float* scal = (const float*)(p.ws + W_SCAL);
  char* blob = p.ws + W_SSDB + (size_t)it * SSD_BLOB;
  bf16_t* Qg = (bf16_t*)blob; bf16_t* KdT = Qg + 64 * 128; bf16_t* QKd = KdT + 128 * 64;
  for (int idx = tid; idx < 64 * 16; idx += NTHR) {
    const int r = idx >> 4, c8 = (idx & 15) * 8;
    *(uint4*)(qS + r * LD + c8) = *(const uint4*)(xbc + (size_t)(t0 + r) * CONV_CH + 4352 + g * 128 + c8);
    *(uint4*)(kS + r * LD + c8) = *(const uint4*)(xbc + (size_t)(t0 + r) * CONV_CH + 4096 + g * 128 + c8);
  }
  if (tid < 64) {
    float la = scal[(size_t)(t0 + tid) * 48 + 32 + h];
    float gc = wave_incl_scan(la, lane);
    gcS[tid] = gc; jsS[tid] = scal[(size_t)(t0 + tid) * 48 + 16 + h]; betaS[tid] = 0.f;
    if (tid == 63) ((float*)(p.ws + W_DEC))[2048 + it] = __expf(gc);
  }
  __syncthreads();
  qk_blobs<128>(qS, kS, gcS, jsS, betaS, Qg, KdT, QKd, nullptr);
  __syncthreads();
}

__device__ __forceinline__ void rope_sincos(float pos, int dd, float& s, float& c) {
  const float inv = exp2f(-(float)dd * 0.10381025296523008f);
  const float ang = pos * inv;
  double r = (double)ang * 0.15915494309189535; r -= floor(r);
  const float fr = (float)r;
  s = __builtin_amdgcn_sinf(fr); c = __builtin_amdgcn_cosf(fr);
}

__device__ __forceinline__ void ret_prep_item(const Params& p, int it, char* lds) {
  constexpr int LD = 264;
  bf16_t* qS = (bf16_t*)lds; bf16_t* kS = qS + 64 * LD; float* gcS = (float*)(kS + 64 * LD); float* jsS = gcS + 64; float* betaS = jsS + 64;
  const int tid = tidx();
  const int bh = it >> 5, c = it & 31, b = bh >> 2, h = bh & 3; const int t0 = b * SEQ + c * 64;
  const bf16_t* pj = (const bf16_t*)(p.ws + W_PROJ1);
  char* blob = p.ws + W_RETB + (size_t)it * RET_BLOB;
  bf16_t* Qg = (bf16_t*)blob; bf16_t* KdT = Qg + 64 * 256; bf16_t* QKd = KdT + 256 * 64;
  for (int idx = tid; idx < 64 * 16; idx += NTHR) {
    const int r = idx >> 4, d8 = (idx & 15) * 8; const float pos = (float)(c * 64 + r);
    float q1[8], q2[8], k1[8], k2[8], oq1[8], oq2[8], ok1[8], ok2[8];
    const bf16_t* row = pj + (size_t)(t0 + r) * RET_IN + h * 256;
    unpack8(*(const uint4*)(row + d8), q1); unpack8(*(const uint4*)(row + 128 + d8), q2);
    unpack8(*(const uint4*)(row + 1024 + d8), k1); unpack8(*(const uint4*)(row + 1024 + 128 + d8), k2);
#pragma unroll
    for (int q = 0; q < 8; ++q) {
      float s, cs; rope_sincos(pos, d8 + q, s, cs);
      oq1[q] = q1[q] * cs - q2[q] * s; oq2[q] = q1[q] * s + q2[q] * cs;
      ok1[q] = (k1[q] * cs - k2[q] * s) * 0.0625f; ok2[q] = (k1[q] * s + k2[q] * cs) * 0.0625f;
    }
    *(uint4*)(qS + r * LD + d8) = pack8(oq1); *(uint4*)(qS + r * LD + 128 + d8) = pack8(oq2);
    *(uint4*)(kS + r * LD + d8) = pack8(ok1); *(uint4*)(kS + r * LD + 128 + d8) = pack8(ok2);
  }
  if (tid < 64) {
    const float lg = log1pf(-exp2f(-5.f - (float)h));
    gcS[tid] = (float)(tid + 1) * lg; jsS[tid] = 1.f; betaS[tid] = 0.f;
    if (tid == 63) ((float*)(p.ws + W_DEC))[6144 + it] = __expf(64.f * lg);
  }
  __syncthreads();
  qk_blobs<256>(qS, kS, gcS, jsS, betaS, Qg, KdT, QKd, nullptr);
  __syncthreads();
}

__device__ __forceinline__ void gdn_sample_item(const Params& p, int it, char* lds) {
  float* ks = (float*)lds; float* qs = ks + 128; float* vs = qs + 128; float* red = vs + 128;
  const int tid = tidx(), lane = tid & 63;
  const int b = it >> 3, h = it & 7; const int t = NPT + b;
  const bf16_t* xr = (const bf16_t*)(p.ws + W_XBC) + (size_t)t * CONV_CH;
  const float* scal = (const float*)(p.ws + W_SCAL) + (size_t)t * 48;
  if (tid < 128) { qs[tid] = bf2f(xr[h * 128 + tid]); ks[tid] = bf2f(xr[1024 + h * 128 + tid]); vs[tid] = bf2f(xr[2048 + h * 128 + tid]); }
  const float beta = scal[h], a = __expf(scal[8 + h]);
  __syncthreads();
  const int e4 = (tid & 31) * 4, dg = tid >> 5;
  const float* S0 = p.state_gdn + (size_t)(b * 8 + h) * 16384;
  float4 S[16]; float4 kS4 = make_float4(0, 0, 0, 0), qS4 = make_float4(0, 0, 0, 0);
#pragma unroll
  for (int i = 0; i < 16; ++i) {
    const int d = dg + 8 * i; S[i] = ldnt4(S0 + d * 128 + e4);
    const float kd = ks[d], qd = qs[d];
    kS4.x += kd * S[i].x; kS4.y += kd * S[i].y; kS4.z += kd * S[i].z; kS4.w += kd * S[i].w;
    qS4.x += qd * S[i].x; qS4.y += qd * S[i].y; qS4.z += qd * S[i].z; qS4.w += qd * S[i].w;
  }
  *(float4*)(red + dg * 128 + e4) = kS4; *(float4*)(red + 1024 + dg * 128 + e4) = qS4;
  float qk = wave_sum(qs[lane] * ks[lane] + qs[lane + 64] * ks[lane + 64]);
  __syncthreads();
  float4 kf = make_float4(0, 0, 0, 0), qf = make_float4(0, 0, 0, 0);
#pragma unroll
  for (int g = 0; g < 8; ++g) {
    float4 u = *(const float4*)(red + g * 128 + e4), v = *(const float4*)(red + 1024 + g * 128 + e4);
    kf.x += u.x; kf.y += u.y; kf.z += u.z; kf.w += u.w; qf.x += v.x; qf.y += v.y; qf.z += v.z; qf.w += v.w;
  }
  const float4 v4 = *(const float4*)(vs + e4);
  float4 u4 = make_float4(beta * (v4.x - a * kf.x), beta * (v4.y - a * kf.y), beta * (v4.z - a * kf.z), beta * (v4.w - a * kf.w));
  float* So = p.out + O_GDNS + (size_t)(b * 8 + h) * 16384;
#pragma unroll
  for (int i = 0; i < 16; ++i) {
    const int d = dg + 8 * i; const float kd = ks[d];
    stnt4(So + d * 128 + e4, make_float4(a * S[i].x + kd * u4.x, a * S[i].y + kd * u4.y, a * S[i].z + kd * u4.z, a * S[i].w + kd * u4.w));
  }
  if (dg == 0) {
    bf16_t* o = (bf16_t*)(p.ws + W_ORAW) + (size_t)t * 2048 + h * 128 + e4;
    *(uint2*)o = make_uint2(pk2(a * qf.x + qk * u4.x, a * qf.y + qk * u4.y), pk2(a * qf.z + qk * u4.z, a * qf.w + qk * u4.w));
  }
  __syncthreads();
}
__device__ __forceinline__ void ssd_sample_item(const Params& p, int it, char* lds) {
  float* ks = (float*)lds; float* qs = ks + 128; float* vs = qs + 128; float* red = vs + 64;
  const int tid = tidx();
  const int b = it >> 4, h = it & 15, g = h >> 3; const int t = NPT + b;
  const bf16_t* xr = (const bf16_t*)(p.ws + W_XBC) + (size_t)t * CONV_CH;
  const float* scal = (const float*)(p.ws + W_SCAL) + (size_t)t * 48;
  const float dt = scal[16 + h], a = __expf(scal[32 + h]);
  if (tid < 128) { ks[tid] = bf2f(xr[4096 + g * 128 + tid]) * dt; qs[tid] = bf2f(xr[4352 + g * 128 + tid]); }
  if (tid < 64) vs[tid] = bf2f(xr[3072 + h * 64 + tid]);
  __syncthreads();
  const int p4 = (tid & 15) * 4, ng = tid >> 4;
  const float* S0 = p.state_ssm + (size_t)(b * 16 + h) * 8192;
  float* So = p.out + O_SSMS + (size_t)(b * 16 + h) * 8192;
  const float4 v4 = *(const float4*)(vs + p4);
  float4 o4 = make_float4(0, 0, 0, 0);
#pragma unroll
  for (int i = 0; i < 8; ++i) {
    const int n = ng + 16 * i; float4 s = ldnt4(S0 + n * 64 + p4);
    const float kn = ks[n], qn = qs[n];
    s.x = a * s.x + kn * v4.x; s.y = a * s.y + kn * v4.y; s.z = a * s.z + kn * v4.z; s.w = a * s.w + kn * v4.w;
    stnt4(So + n * 64 + p4, s);
    o4.x += qn * s.x; o4.y += qn * s.y; o4.z += qn * s.z; o4.w += qn * s.w;
  }
  *(float4*)(red + ng * 64 + p4) = o4;
  __syncthreads();
  if (tid < 16) {
    float4 s = make_float4(0, 0, 0, 0);
#pragma unroll
    for (int gg = 0; gg < 16; ++gg) { float4 u = *(const float4*)(red + gg * 64 + tid * 4); s.x += u.x; s.y += u.y; s.z += u.z; s.w += u.w; }
    bf16_t* o = (bf16_t*)(p.ws + W_ORAW) + (size_t)t * 2048 + 1024 + h * 64 + tid * 4;
    *(uint2*)o = make_uint2(pk2(s.x, s.y), pk2(s.z, s.w));
  }
  __syncthreads();
}
__device__ __forceinline__ void ret_sample_item(const Params& p, int it, char* lds) {
  float* ks = (float*)lds; float* qs = ks + 256; float* vs = qs + 256; float* red = vs + 128;
  const int tid = tidx();
  const int sl = it & 3, bh = it >> 2, b = bh >> 2, h = bh & 3; const int t = NPT + b; const int e0 = sl * 128;
  const bf16_t* row = (const bf16_t*)(p.ws + W_PROJ1) + (size_t)t * RET_IN;
  {
    const int d = tid, dd = d & 127;
    float s, c; rope_sincos(16384.f, dd, s, c);
    const float q1 = bf2f(row[h * 256 + dd]), q2 = bf2f(row[h * 256 + 128 + dd]);
    const float k1 = bf2f(row[1024 + h * 256 + dd]), k2 = bf2f(row[1024 + h * 256 + 128 + dd]);
    qs[d] = d < 128 ? q1 * c - q2 * s : q1 * s + q2 * c;
    ks[d] = (d < 128 ? k1 * c - k2 * s : k1 * s + k2 * c) * 0.0625f;
    if (tid < 128) vs[tid] = bf2f(row[2048 + h * 512 + e0 + tid]);
  }
  __syncthreads();
  const float gamma = 1.f - exp2f(-5.f - (float)h);
  const int e4 = (tid & 31) * 4, dg = tid >> 5;
  const float* S0 = p.state_ret + (size_t)(b * 4 + h) * 131072 + e0;
  float* So = p.out + O_RETS + (size_t)(b * 4 + h) * 131072 + e0;
  const float4 v4 = *(const float4*)(vs + e4);
  float4 o4 = make_float4(0, 0, 0, 0);
#pragma unroll 8
  for (int i = 0; i < 32; ++i) {
    const int d = dg + 8 * i; float4 s = ldnt4(S0 + (size_t)d * 512 + e4);
    const float kn = ks[d], qn = qs[d];
    s.x = gamma * s.x + kn * v4.x; s.y = gamma * s.y + kn * v4.y; s.z = gamma * s.z + kn * v4.z; s.w = gamma * s.w + kn * v4.w;
    stnt4(So + (size_t)d * 512 + e4, s);
    o4.x += qn * s.x; o4.y += qn * s.y; o4.z += qn * s.z; o4.w += qn * s.w;
  }
  *(float4*)(red + dg * 128 + e4) = o4;
  __syncthreads();
  if (tid < 32) {
    float4 s = make_float4(0, 0, 0, 0);
#pragma unroll
    for (int gg = 0; gg < 8; ++gg) { float4 u = *(const float4*)(red + gg * 128 + tid * 4); s.x += u.x; s.y += u.y; s.z += u.z; s.w += u.w; }
    bf16_t* o = (bf16_t*)(p.ws + W_ORAW) + (size_t)t * 2048 + h * 512 + e0 + tid * 4;
    *(uint2*)o = make_uint2(pk2(s.x, s.y), pk2(s.z, s.w));
  }
  __syncthreads();
}

__device__ __forceinline__ void lds_barrier() { asm volatile("s_waitcnt lgkmcnt(0)\n\ts_barrier" ::: "memory"); }
template <int DK, int DVS, bool HAS_W>
__device__ __forceinline__ void scan_item(const char* blob0, size_t blob_stride, const float* dec,
                                          const bf16_t* U0, size_t u_stride, size_t u_cstride,
                                          bf16_t* O, size_t o_stride, float* Sout, int s_stride, char* lds) {
  constexpr int NT = DVS / 16, MT = DK / 64, KS = DK / 32, LS = DK + 8, LU = 72;
  bf16_t* Sbt = (bf16_t*)lds; bf16_t* Ubt = Sbt + DVS * LS;
  const int tid = tidx(), lane = tid & 63, w = tid >> 6, fr = lane & 15, fq = lane >> 4;
  f32x4 Sacc[MT][NT];
#pragma unroll
  for (int m = 0; m < MT; ++m)
#pragma unroll
    for (int n = 0; n < NT; ++n) Sacc[m][n] = (f32x4){0.f, 0.f, 0.f, 0.f};
  for (int i = tid; i < DVS * LS / 8; i += NTHR) ((uint4*)Sbt)[i] = make_uint4(0, 0, 0, 0);
  bf16_t u0r[NT][4]; bf16x8 wn[KS];
  {
    const bf16_t* Wn0 = (const bf16_t*)blob0 + 64 * DK + DK * 64 + 4096;
#pragma unroll
    for (int n = 0; n < NT; ++n)
#pragma unroll
      for (int jj = 0; jj < 4; ++jj) u0r[n][jj] = U0[(size_t)(16 * w + fq * 4 + jj) * u_stride + n * 16 + fr];
    if (HAS_W) {
#pragma unroll
      for (int ks = 0; ks < KS; ++ks) wn[ks] = ld16(Wn0 + (16 * w + fr) * DK + ks * 32 + fq * 8);
    }
  }
  __syncthreads();
#pragma unroll 1
  for (int c = 0; c < 32; ++c) {
    const bf16_t* Qg = (const bf16_t*)(blob0 + (size_t)c * blob_stride);
    const bf16_t* KdT = Qg + 64 * DK; const bf16_t* QKd = KdT + DK * 64;
    bf16x8 qg[KS], qkd[2], kdt[MT][2];
#pragma unroll
    for (int ks = 0; ks < KS; ++ks) qg[ks] = ld16(Qg + (16 * w + fr) * DK + ks * 32 + fq * 8);
#pragma unroll
    for (int ks = 0; ks < 2; ++ks) qkd[ks] = ld16(QKd + (16 * w + fr) * 64 + ks * 32 + fq * 8);
#pragma unroll
    for (int m = 0; m < MT; ++m)
#pragma unroll
      for (int ks = 0; ks < 2; ++ks) kdt[m][ks] = ld16(KdT + (w * (DK / 4) + m * 16 + fr) * 64 + ks * 32 + fq * 8);
    const float dc = dec[c];
    f32x4 Uacc[NT];
#pragma unroll
    for (int n = 0; n < NT; ++n)
#pragma unroll
      for (int jj = 0; jj < 4; ++jj) Uacc[n][jj] = bf2f(u0r[n][jj]);
    if (HAS_W) {
#pragma unroll
      for (int ks = 0; ks < KS; ++ks) {
#pragma unroll
        for (int n = 0; n < NT; ++n) { bf16x8 bb = *(const bf16x8*)(Sbt + (n * 16 + fr) * LS + ks * 32 + fq * 8); Uacc[n] = mfma16(wn[ks], bb, Uacc[n]); }
      }
    }
    {
      const int cn = (c + 1 < 32) ? c + 1 : c;
      const bf16_t* Wnn = (const bf16_t*)(blob0 + (size_t)cn * blob_stride) + 64 * DK + DK * 64 + 4096;
#pragma unroll
      for (int n = 0; n < NT; ++n)
#pragma unroll
        for (int jj = 0; jj < 4; ++jj) u0r[n][jj] = U0[(size_t)cn * u_cstride + (size_t)(16 * w + fq * 4 + jj) * u_stride + n * 16 + fr];
      if (HAS_W) {
#pragma unroll
        for (int ks = 0; ks < KS; ++ks) wn[ks] = ld16(Wnn + (16 * w + fr) * DK + ks * 32 + fq * 8);
      }
    }
#pragma unroll
    for (int n = 0; n < NT; ++n) *(uint2*)(Ubt + (n * 16 + fr) * LU + 16 * w + fq * 4) = make_uint2(pk2(Uacc[n][0], Uacc[n][1]), pk2(Uacc[n][2], Uacc[n][3]));
    lds_barrier();
    f32x4 Oacc[NT];
#pragma unroll
    for (int n = 0; n < NT; ++n) Oacc[n] = (f32x4){0.f, 0.f, 0.f, 0.f};
#pragma unroll
    for (int ks = 0; ks < KS; ++ks) {
#pragma unroll
      for (int n = 0; n < NT; ++n) { bf16x8 a = *(const bf16x8*)(Sbt + (n * 16 + fr) * LS + ks * 32 + fq * 8); Oacc[n] = mfma16(a, qg[ks], Oacc[n]); }
    }
    bf16x8 ub[2][NT];
#pragma unroll
    for (int ks = 0; ks < 2; ++ks)
#pragma unroll
      for (int n = 0; n < NT; ++n) ub[ks][n] = *(const bf16x8*)(Ubt + (n * 16 + fr) * LU + ks * 32 + fq * 8);
#pragma unroll
    for (int ks = 0; ks < 2; ++ks)
#pragma unroll
      for (int n = 0; n < NT; ++n) Oacc[n] = mfma16(ub[ks][n], qkd[ks], Oacc[n]);
#pragma unroll
    for (int n = 0; n < NT; ++n)
      *(uint2*)(O + (size_t)(c * 64 + 16 * w + fr) * o_stride + n * 16 + fq * 4) = make_uint2(pk2(Oacc[n][0], Oacc[n][1]), pk2(Oacc[n][2], Oacc[n][3]));
#pragma unroll
    for (int m = 0; m < MT; ++m)
#pragma unroll
      for (int n = 0; n < NT; ++n) Sacc[m][n] = Sacc[m][n] * dc;
#pragma unroll
    for (int ks = 0; ks < 2; ++ks)
#pragma unroll
      for (int m = 0; m < MT; ++m)
#pragma unroll
        for (int n = 0; n < NT; ++n) Sacc[m][n] = mfma16(kdt[m][ks], ub[ks][n], Sacc[m][n]);
    lds_barrier();
#pragma unroll
    for (int m = 0; m < MT; ++m)
#pragma unroll
      for (int n = 0; n < NT; ++n)
        *(uint2*)(Sbt + (n * 16 + fr) * LS + w * (DK / 4) + m * 16 + fq * 4) = make_uint2(pk2(Sacc[m][n][0], Sacc[m][n][1]), pk2(Sacc[m][n][2], Sacc[m][n][3]));
    lds_barrier();
  }
#pragma unroll
  for (int m = 0; m < MT; ++m)
#pragma unroll
    for (int n = 0; n < NT; ++n)
#pragma unroll
      for (int jj = 0; jj < 4; ++jj) Sout[(size_t)(w * (DK / 4) + m * 16 + fq * 4 + jj) * s_stride + n * 16 + fr] = Sacc[m][n][jj];
  __syncthreads();
}

__device__ __forceinline__ int queue_next(unsigned* ctr) {
  __shared__ int q_item;
  if (threadIdx.x == 0) q_item = (int)__hip_atomic_fetch_add(ctr, 1u, __ATOMIC_RELAXED, __HIP_MEMORY_SCOPE_AGENT);
  __syncthreads();
  const int it = q_item;
  __syncthreads();
  return it;
}
__device__ __forceinline__ void phase_prep_ab(const Params& p, char* lds) {
  const int NIT = 2048 + 4096;
  for (int it = blockIdx.x; it < NIT; it += gridDim.x) {
    if (it < 2048) gdn_prep_item(p, it, lds); else ssd_prep_item(p, it - 2048, lds);
  }
}
__device__ __forceinline__ void phase_scan_ab(const Params& p, char* lds) {
  constexpr int DVS = 64;
  const int N_G = 64 * (128 / DVS), N_S = 128 * (64 / DVS);
  bf16_t* oraw = (bf16_t*)(p.ws + W_ORAW);
  const float* dec = (const float*)(p.ws + W_DEC);
  const int half = gridDim.x >> 1;
  if ((int)blockIdx.x < half)
  for (int it = blockIdx.x; it < N_G + N_S; it += half) {
    if (it < N_G) {
      const int bh = it / (128 / DVS), sl = it % (128 / DVS), b = bh >> 3, h = bh & 7, e0 = sl * DVS;
      const char* blob0 = p.ws + W_GDNB + (size_t)(bh * 32) * GDN_BLOB;
      scan_item<128, DVS, true>(blob0, GDN_BLOB, dec + bh * 32, (const bf16_t*)(blob0 + 57344) + e0, 128, GDN_BLOB / 2,
                                oraw + (size_t)(b * SEQ) * 2048 + h * 128 + e0, 2048,
                                p.out + O_GDNP + (size_t)bh * 16384 + e0, 128, lds);
    } else {
      const int r = it - N_G; const int bh = r / (64 / DVS), sl = r % (64 / DVS), b = bh >> 4, h = bh & 15, e0 = sl * DVS;
      const char* blob0 = p.ws + W_SSDB + (size_t)(bh * 32) * SSD_BLOB;
      scan_item<128, DVS, false>(blob0, SSD_BLOB, dec + 2048 + bh * 32,
                                 (const bf16_t*)(p.ws + W_XBC) + (size_t)(b * SEQ) * CONV_CH + 3072 + h * 64 + e0, CONV_CH, (size_t)64 * CONV_CH,
                                 oraw + (size_t)(b * SEQ) * 2048 + 1024 + h * 64 + e0, 2048,
                                 p.out + O_SSMP + (size_t)bh * 8192 + e0, 64, lds);
    }
  }
  unsigned* qctr = (unsigned*)(p.ws + W_BAR) + 8;
  for (;;) {
    const int it = queue_next(qctr);
    if (it >= 1024 + 2048) break;
    if (it < 1024) gdn_sample_item(p, it, lds); else ssd_sample_item(p, it - 1024, lds);
  }
}
__device__ __forceinline__ void phase_prep_ret(const Params& p, char* lds) {
  for (int it = blockIdx.x; it < 1024; it += gridDim.x) ret_prep_item(p, it, lds);
}
__device__ __forceinline__ void phase_scan_ret(const Params& p, char* lds) {
  constexpr int DVS = 64;
  const int NS = 512 / DVS;
  bf16_t* oraw = (bf16_t*)(p.ws + W_ORAW);
  const float* dec = (const float*)(p.ws + W_DEC) + 6144;
  const int half = gridDim.x >> 1;
  if ((int)blockIdx.x < half)
  for (int it = blockIdx.x; it < 32 * NS; it += half) {
    const int bh = it / NS, sl = it % NS, b = bh >> 2, h = bh & 3, e0 = sl * DVS;
    const char* blob0 = p.ws + W_RETB + (size_t)(bh * 32) * RET_BLOB;
    scan_item<256, DVS, false>(blob0, RET_BLOB, dec + bh * 32,
                               (const bf16_t*)(p.ws + W_PROJ1) + (size_t)(b * SEQ) * RET_IN + 2048 + h * 512 + e0, RET_IN, (size_t)64 * RET_IN,
                               oraw + (size_t)(b * SEQ) * 2048 + h * 512 + e0, 2048,
                               p.out + O_RETP + (size_t)bh * 131072 + e0, 512, lds);
  }
  unsigned* qctr = (unsigned*)(p.ws + W_BAR) + 24;
  for (;;) {
    const int it = queue_next(qctr);
    if (it >= 2048) break;
    ret_sample_item(p, it, lds);
  }
}

__device__ __forceinline__ void phase_post_ab(const Params& p) {
  const int lane = tidx() & 63, wave = tidx() >> 6;
  const bf16_t* oraw = (const bf16_t*)(p.ws + W_ORAW); const bf16_t* gz = (const bf16_t*)(p.ws + W_GZ);
  const bf16_t* xbc = (const bf16_t*)(p.ws + W_XBC); bf16_t* a2 = (bf16_t*)(p.ws + W_A2);
  for (int t = blockIdx.x * 4 + wave; t < NTOK; t += gridDim.x * 4) {
#pragma unroll
    for (int j = 0; j < 2; ++j) {
      const int c = j * 512 + lane * 8;
      float o[8], gt[8], gn[8];
      unpack8(ldnt_u4(oraw + (size_t)t * 2048 + c), o); unpack8(ldnt_u4(gz + (size_t)t * GZ_W + c), gt);
      load8f(p.gdn_norm_g + (c & 127), gn);
      float ss = 0.f;
#pragma unroll
      for (int i = 0; i < 8; ++i) ss += o[i] * o[i];
      ss = grp16_sum(ss);
      const float rstd = rsqrtf(ss * (1.f / 128.f) + 1e-6f);
#pragma unroll
      for (int i = 0; i < 8; ++i) o[i] = o[i] * rstd * gn[i] * siluf_(gt[i]);
      *(uint4*)(a2 + (size_t)t * 2048 + c) = pack8(o);
    }
    float ob[16]; float ss = 0.f;
#pragma unroll
    for (int j = 0; j < 2; ++j) {
      const int c = j * 512 + lane * 8;
      float o[8], xs[8], z[8];
      unpack8(ldnt_u4(oraw + (size_t)t * 2048 + 1024 + c), o); unpack8(ldnt_u4(xbc + (size_t)t * CONV_CH + 3072 + c), xs);
      unpack8(ldnt_u4(gz + (size_t)t * GZ_W + 1024 + c), z);
      const float dd = p.ssm_d[c >> 6];
#pragma unroll
      for (int i = 0; i < 8; ++i) { float v = (o[i] + dd * xs[i]) * siluf_(z[i]); ob[j * 8 + i] = v; ss += v * v; }
    }
    ss = wave_sum(ss);
    const float rstd = rsqrtf(ss * (1.f / 1024.f) + 1e-6f);
#pragma unroll
    for (int j = 0; j < 2; ++j) {
      const int c = j * 512 + lane * 8;
      float gn[8], o[8]; load8f(p.ssm_norm_g + c, gn);
#pragma unroll
      for (int i = 0; i < 8; ++i) o[i] = ob[j * 8 + i] * rstd * gn[i];
      *(uint4*)(a2 + (size_t)t * 2048 + 1024 + c) = pack8(o);
    }
  }
}
__device__ __forceinline__ void phase_post_ret(const Params& p) {
  const int lane = tidx() & 63, wave = tidx() >> 6;
  const bf16_t* oraw = (const bf16_t*)(p.ws + W_ORAW); const bf16_t* pj = (const bf16_t*)(p.ws + W_PROJ1); bf16_t* a2 = (bf16_t*)(p.ws + W_A2);
  for (int t = blockIdx.x * 4 + wave; t < NTOK; t += gridDim.x * 4) {
#pragma unroll
    for (int h = 0; h < 4; ++h) {
      const int c = h * 512 + lane * 8;
      float o[8], gt[8], gn[8];
      unpack8(ldnt_u4(oraw + (size_t)t * 2048 + c), o); unpack8(ldnt_u4(pj + (size_t)t * RET_IN + 4096 + c), gt);
      load8f(p.ret_norm_g + c, gn);
      float s = 0.f;
#pragma unroll
      for (int i = 0; i < 8; ++i) s += o[i];
      const float mu = wave_sum(s) * (1.f / 512.f);
      float vs = 0.f;
#pragma unroll
      for (int i = 0; i < 8; ++i) { o[i] -= mu; vs += o[i] * o[i]; }
      const float rstd = rsqrtf(wave_sum(vs) * (1.f / 512.f) + 1e-6f);
#pragma unroll
      for (int i = 0; i < 8; ++i) o[i] = o[i] * rstd * gn[i] * siluf_(gt[i]);
      *(uint4*)(a2 + (size_t)t * 2048 + c) = pack8(o);
    }
  }
}

__device__ __forceinline__ void phase_topk(const Params& p, int layer, char* lds) {
  float* sc = (float*)lds;
  float* tkv = sc + 128 * 129;
  unsigned char* tki = (unsigned char*)(tkv + 128 * 16);
  const int tid = tidx(), lane = tid & 63, w = tid >> 6, fr = lane & 15, fq = lane >> 4;
  const bf16_t* qb = (const bf16_t*)(p.ws + W_ORAW);
  const bf16_t* keys = (const bf16_t*)(p.ws + W_KEYS) + (size_t)layer * 2 * 128 * 128;
  int* oidx = (int*)(p.ws + W_TKI); float* ogate = (float*)(p.ws + W_TKG);
  for (int item = blockIdx.x; item < 258 * 8; item += gridDim.x) {
    const int tt = item >> 3, h = item & 7, t0 = tt * 64;
#pragma unroll 1
    for (int pp = 0; pp < 2; ++pp) {
      f32x4 acc[8];
#pragma unroll
      for (int n = 0; n < 8; ++n) acc[n] = (f32x4){0.f, 0.f, 0.f, 0.f};
      __builtin_amdgcn_s_setprio(1);
#pragma unroll
      for (int ks = 0; ks < 4; ++ks) {
        bf16x8 bq = ld16(qb + (size_t)(t0 + 16 * w + fr) * 2048 + h * 256 + pp * 128 + ks * 32 + fq * 8);
#pragma unroll
        for (int n = 0; n < 8; ++n) { bf16x8 a = ld16(keys + (size_t)(pp * 128 + n * 16 + fr) * 128 + ks * 32 + fq * 8); acc[n] = mfma16(a, bq, acc[n]); }
      }
      __builtin_amdgcn_s_setprio(0);
#pragma unroll
      for (int n = 0; n < 8; ++n)
#pragma unroll
        for (int jj = 0; jj < 4; ++jj) sc[((16 * w + fr) * 2 + pp) * 129 + n * 16 + fq * 4 + jj] = acc[n][jj];
    }
    __syncthreads();
    {
      const int row = tid >> 1, hf = tid & 1; float* r = sc + row * 129 + hf;
      float gmax[8];
#pragma unroll
      for (int g = 0; g < 8; ++g) {
        float m = r[2 * (8 * g)];
#pragma unroll
        for (int i = 1; i < 8; ++i) m = fmaxf(m, r[2 * (8 * g + i)]);
        gmax[g] = m;
      }
#pragma unroll 1
      for (int it = 0; it < 16; ++it) {
        float best = gmax[0]; int bg = 0;
#pragma unroll
        for (int g = 1; g < 8; ++g) if (gmax[g] > best) { best = gmax[g]; bg = g; }
        int bj = 8 * bg + 7;
#pragma unroll
        for (int i = 6; i >= 0; --i) if (r[2 * (8 * bg + i)] == best) bj = 8 * bg + i;
        int bi = 2 * bj + hf;
        const float ov = __shfl_xor(best, 1); const int oi = __shfl_xor(bi, 1);
        const bool take = (ov > best) || (ov == best && oi < bi);
        if (!take) {
          r[2 * bj] = -INFINITY;
          float m = r[2 * (8 * bg)];
#pragma unroll
          for (int i = 1; i < 8; ++i) m = fmaxf(m, r[2 * (8 * bg + i)]);
#pragma unroll
          for (int g = 0; g < 8; ++g) if (g == bg) gmax[g] = m;
        }
        if (hf == 0) { tkv[row * 16 + it] = take ? ov : best; tki[row * 16 + it] = (unsigned char)(take ? oi : bi); }
      }
    }
    __syncthreads();
    {
      const int tok = tid >> 2, qd = tid & 3;
      const float* v0 = tkv + (tok * 2) * 16; const float* v1 = v0 + 16;
      float a0[4]; int ptr[4];
#pragma unroll
      for (int i = 0; i < 4; ++i) { a0[i] = v0[qd * 4 + i]; ptr[i] = 0; }
      float cv[16]; int ci[16];
#pragma unroll
      for (int it = 0; it < 16; ++it) {
        float best = -INFINITY; int bidx = 1 << 30;
#pragma unroll
        for (int i = 0; i < 4; ++i) {
          const float cnd = (ptr[i] < 16) ? a0[i] + v1[ptr[i] & 15] : -INFINITY; const int fi = (qd * 4 + i) * 16 + ptr[i];
          if (cnd > best || (cnd == best && fi < bidx)) { best = cnd; bidx = fi; }
        }
#pragma unroll
        for (int off = 1; off < 4; off <<= 1) {
          const float ov = __shfl_xor(best, off); const int oi = __shfl_xor(bidx, off);
          if (ov > best || (ov == best && oi < bidx)) { best = ov; bidx = oi; }
        }
        const int wa = bidx >> 4;
#pragma unroll
        for (int i = 0; i < 4; ++i) if (wa == qd * 4 + i) ptr[i]++;
        cv[it] = best; ci[it] = bidx;
      }
      const float m = cv[0];
      float ev[16]; float es = 0.f;
#pragma unroll
      for (int it = 0; it < 16; ++it) { ev[it] = __expf(cv[it] - m); es += ev[it]; }
      const float inv = 1.f / es;
      const unsigned char* i0 = tki + (tok * 2) * 16; const unsigned char* i1 = i0 + 16;
      const size_t ob = ((size_t)(t0 + tok) * 8 + h) * 16;
#pragma unroll
      for (int it = 0; it < 16; ++it) {
        if ((it >> 2) == qd) { oidx[ob + it] = (int)i0[ci[it] >> 4] * 128 + (int)i1[ci[it] & 15]; ogate[ob + it] = ev[it] * inv; }
      }
    }
    __syncthreads();
  }
}

__device__ __forceinline__ void deq16(uint4 r, f32x2_t* f) {
  f[0] = __builtin_amdgcn_cvt_pk_f32_fp8((int)r.x, false); f[1] = __builtin_amdgcn_cvt_pk_f32_fp8((int)r.x, true);
  f[2] = __builtin_amdgcn_cvt_pk_f32_fp8((int)r.y, false); f[3] = __builtin_amdgcn_cvt_pk_f32_fp8((int)r.y, true);
  f[4] = __builtin_amdgcn_cvt_pk_f32_fp8((int)r.z, false); f[5] = __builtin_amdgcn_cvt_pk_f32_fp8((int)r.z, true);
  f[6] = __builtin_amdgcn_cvt_pk_f32_fp8((int)r.w, false); f[7] = __builtin_amdgcn_cvt_pk_f32_fp8((int)r.w, true);
}
__device__ __forceinline__ void gather_groups(const unsigned char* U, const unsigned char* V, const bf16_t* hm, const int* tki, const float* tkg,
                                              int t, int gb, int ge, int lane, f32x2_t* y) {
  f32x2_t xv[8];
  {
    float f[16];
    unpack8(*(const uint4*)(hm + (size_t)t * D + lane * 16), f); unpack8(*(const uint4*)(hm + (size_t)t * D + lane * 16 + 8), f + 8);
#pragma unroll
    for (int i = 0; i < 8; ++i) xv[i] = (f32x2_t){f[2 * i], f[2 * i + 1]};
  }
  const int id0 = tki[(size_t)t * 128 + lane], id1 = tki[(size_t)t * 128 + 64 + lane];
  const float g0 = tkg[(size_t)t * 128 + lane], g1 = tkg[(size_t)t * 128 + 64 + lane];
  uint4 ra[8], rb[8]; int rida[8], ridb[8]; float gta[8], gtb[8];
#define G_LOADU(R, RID, GT, g) _Pragma("unroll") for (int e = 0; e < 8; ++e) { \
    const int k = ((g) * 8 + e) & 63; \
    RID[e] = __builtin_amdgcn_readlane((g) < 8 ? id0 : id1, k); \
    R[e] = *(const uint4*)(U + (size_t)RID[e] * 1024 + lane * 16); }
#define G_DOTS(R, RID, GT, g) { float dl = 0.f; \
    _Pragma("unroll") for (int e = 0; e < 8; ++e) { \
      f32x2_t f[8]; deq16(R[e], f); f32x2_t d2 = f[0] * xv[0]; \
      _Pragma("unroll") for (int i = 1; i < 8; ++i) d2 += f[i] * xv[i]; \
      const float d = wave_sum_fast(d2[0] + d2[1]); \
      dl = (lane == (((g) * 8 + e) & 63)) ? d : dl; \
      R[e] = *(const uint4*)(V + (size_t)RID[e] * 1024 + lane * 16); } \
    const float al = geluf_(dl * (1.f / U_SCALE)) * ((g) < 8 ? g0 : g1) * (1.f / V_SCALE);     \
    _Pragma("unroll") for (int e = 0; e < 8; ++e) GT[e] = __int_as_float(__builtin_amdgcn_readlane(__float_as_int(al), ((g) * 8 + e) & 63)); }
#define G_ACC(R, GT) _Pragma("unroll") for (int e = 0; e < 8; ++e) { \
    f32x2_t f[8]; deq16(R[e], f); const f32x2_t a2 = (f32x2_t){GT[e], GT[e]}; \
    _Pragma("unroll") for (int i = 0; i < 8; ++i) y[i] += a2 * f[i]; }
  G_LOADU(ra, rida, gta, gb)
#pragma unroll 1
  for (int g = gb; g < ge; g += 2) {
    G_DOTS(ra, rida, gta, g)
    G_LOADU(rb, ridb, gtb, g + 1)
    __builtin_amdgcn_sched_barrier(0);
    G_ACC(ra, gta)
    G_DOTS(rb, ridb, gtb, g + 1)
    if (g + 2 < ge) { G_LOADU(ra, rida, gta, g + 2) }
    __builtin_amdgcn_sched_barrier(0);
    G_ACC(rb, gtb)
  }
#undef G_LOADU
#undef G_DOTS
#undef G_ACC
}
__device__ __forceinline__ void gather_epilogue(const Params& p, int layer, int t, const f32x2_t* y, int lane) {
  bf16_t* hm = (bf16_t*)(p.ws + W_HM);
  float* xws = (float*)(p.ws + W_X);
  const float* mod = (const float*)(p.ws + W_MOD);
  const int c0 = lane * 16;
  const float* mr = mod + (size_t)seq_row(t) * 12288 + layer * 6144;
  float xr[16]; float ss = 0.f;
  {
    float xo[16], g2[16];
    load8f(xws + (size_t)t * D + c0, xo); load8f(xws + (size_t)t * D + c0 + 8, xo + 8);
    load8f(mr + 5 * 1024 + c0, g2); load8f(mr + 5 * 1024 + c0 + 8, g2 + 8);
#pragma unroll
    for (int i = 0; i < 16; ++i) { const float v = xo[i] + g2[i] * y[i >> 1][i & 1]; xr[i] = v; ss += v * v; }
  }
  ss = wave_sum(ss);
  const float rstd = rsqrtf(ss * (1.f / D) + 1e-6f);
  if (layer == 0) {
    store8f(xws + (size_t)t * D + c0, xr); store8f(xws + (size_t)t * D + c0 + 8, xr + 8);
    const float* m1 = mod + (size_t)seq_row(t) * 12288 + 6144;
    float gg[16], s1[16], s2[16], o[16];
    load8f(p.norm1_g + D + c0, gg); load8f(p.norm1_g + D + c0 + 8, gg + 8);
    load8f(m1 + 1024 + c0, s1); load8f(m1 + 1024 + c0 + 8, s1 + 8);
    load8f(m1 + c0, s2); load8f(m1 + c0 + 8, s2 + 8);
#pragma unroll
    for (int i = 0; i < 16; ++i) o[i] = xr[i] * rstd * gg[i] * (1.f + s1[i]) + s2[i];
    *(uint4*)(hm + (size_t)t * D + c0) = pack8(o); *(uint4*)(hm + (size_t)t * D + c0 + 8) = pack8(o + 8);
  } else {
    float gg[16], o[16];
    load8f(p.final_g + c0, gg); load8f(p.final_g + c0 + 8, gg + 8);
#pragma unroll
    for (int i = 0; i < 16; ++i) o[i] = xr[i] * rstd * gg[i];
    { float* yo = p.out + O_Y + (size_t)t * D + c0;
      stnt4(yo, make_float4(o[0], o[1], o[2], o[3])); stnt4(yo + 4, make_float4(o[4], o[5], o[6], o[7]));
      stnt4(yo + 8, make_float4(o[8], o[9], o[10], o[11])); stnt4(yo + 12, make_float4(o[12], o[13], o[14], o[15])); }
  }
}
__device__ __forceinline__ void phase_gather(const Params& p, int layer, char* lds) {
  const int lane = tidx() & 63, wave = tidx() >> 6;
  const unsigned char* U = (const unsigned char*)(p.ws + W_U) + (size_t)layer * 16384 * 1024;
  const unsigned char* V = (const unsigned char*)(p.ws + W_V) + (size_t)layer * 16384 * 1024;
  const bf16_t* hm = (const bf16_t*)(p.ws + W_HM);
  const int* tki = (const int*)(p.ws + W_TKI); const float* tkg = (const float*)(p.ws + W_TKG);
  for (int t = blockIdx.x * 4 + wave; t < NPT; t += gridDim.x * 4) {
    f32x2_t y[8];
#pragma unroll
    for (int i = 0; i < 8; ++i) y[i] = (f32x2_t){0.f, 0.f};
    gather_groups(U, V, hm, tki, tkg, t, 0, 16, lane, y);
    gather_epilogue(p, layer, t, y, lane);
  }
  float* part = (float*)lds;
  for (int tt = blockIdx.x; tt < NTOK - NPT; tt += gridDim.x) {
    const int t = NPT + tt;
    f32x2_t y[8];
#pragma unroll
    for (int i = 0; i < 8; ++i) y[i] = (f32x2_t){0.f, 0.f};
    gather_groups(U, V, hm, tki, tkg, t, wave * 4, wave * 4 + 4, lane, y);
#pragma unroll
    for (int i = 0; i < 8; ++i) *(f32x2_t*)(part + wave * 1024 + lane * 16 + 2 * i) = y[i];
    __syncthreads();
    if (wave == 0) {
#pragma unroll
      for (int i = 0; i < 8; ++i) {
        f32x2_t a = *(const f32x2_t*)(part + lane * 16 + 2 * i);
        a += *(const f32x2_t*)(part + 1024 + lane * 16 + 2 * i); a += *(const f32x2_t*)(part + 2048 + lane * 16 + 2 * i); a += *(const f32x2_t*)(part + 3072 + lane * 16 + 2 * i);
        y[i] = a;
      }
      gather_epilogue(p, layer, t, y, lane);
    }
    __syncthreads();
  }
}

#define XB_TMO      128
#define XB_XCNT(j)  (256  + 64 * (j))
#define XB_XSUB(j)  (1280 + 64 * (j))
#define XB_XGEN(j)  (2304 + 64 * (j))
#define XB_TOP      3328
#define XB_TOPGEN   3392
#define XCD_BAR_WORDS 3456
#define XB_SPIN_CAP (1u << 22)
#define LAS __attribute__((address_space(3)))
__device__ __forceinline__ unsigned xb_ld(unsigned* p)              { return __hip_atomic_load(p, __ATOMIC_RELAXED, __HIP_MEMORY_SCOPE_AGENT); }
__device__ __forceinline__ unsigned xb_add(unsigned* p, unsigned v) { return __hip_atomic_fetch_add(p, v, __ATOMIC_RELAXED, __HIP_MEMORY_SCOPE_AGENT); }
__device__ __forceinline__ unsigned xb_xcc_id() { return (unsigned)__builtin_amdgcn_s_getreg((3 << 11) | 20) & 0xFu; }
#define XB_SPIN(cond, bar) do { unsigned _sp = 0; while (cond) { __builtin_amdgcn_s_sleep(1); \
    if ((++_sp & 255u) == 0u) { if (xb_ld(&(bar)[XB_TMO])) break; if (_sp > XB_SPIN_CAP) { atomicAdd(&(bar)[XB_TMO], 1u); break; } } } } while (0)
struct XcdBarrier { unsigned* bar; unsigned x; volatile unsigned* st; };
__device__ __forceinline__ XcdBarrier xcd_barrier_post(unsigned* bar, volatile unsigned* st) {
  XcdBarrier b; b.bar = bar; b.x = xb_xcc_id(); b.st = st;
  if (threadIdx.x == 0) (void)xb_add(&bar[XB_XCNT(b.x)], 1u);
  return b;
}
__device__ __forceinline__ void xcd_barrier_complete(unsigned* bar, unsigned x, unsigned& nloc, unsigned& nx) {
  const unsigned G = gridDim.x;
  unsigned sum, cnt, mine, sp = 0u;
  for (;;) {
    sum = 0u; cnt = 0u; mine = 0u;
#pragma unroll
    for (unsigned j = 0; j < 16; ++j) { const unsigned c = xb_ld(&bar[XB_XCNT(j)]); sum += c; cnt += (c > 0u) ? 1u : 0u; mine = (j == x) ? c : mine; }
    if (sum == G) break;
    __builtin_amdgcn_s_sleep(1);
    if ((++sp & 255u) == 0u) { if (xb_ld(&bar[XB_TMO])) break; if (sp > XB_SPIN_CAP) { atomicAdd(&bar[XB_TMO], 1u); break; } }
  }
  nloc = mine > 0u ? mine : 1u; nx = cnt > 0u ? cnt : 1u;
}
__device__ __forceinline__ void xcd_barrier(const XcdBarrier& b) {
  asm volatile("s_waitcnt vmcnt(0)" ::: "memory");
  __syncthreads();
  if (threadIdx.x == 0) {
    unsigned* bar = b.bar;
    __builtin_amdgcn_s_waitcnt(0);
    unsigned nloc = b.st[0], nx = b.st[1];
    if (nloc == 0u) { xcd_barrier_complete(bar, b.x, nloc, nx); b.st[0] = nloc; b.st[1] = nx; }
    const unsigned old = xb_add(&bar[XB_XSUB(b.x)], 1u);
    const unsigned gen = old / nloc;
    if (old + 1u == (gen + 1u) * nloc) {
      __builtin_amdgcn_fence(__ATOMIC_RELEASE, "agent");
      asm volatile("s_waitcnt vmcnt(0)" ::: "memory");
      const unsigned og = xb_add(&bar[XB_TOP], 1u);
      const unsigned tg = og / nx;
      if (og + 1u == (tg + 1u) * nx) xb_add(&bar[XB_TOPGEN], 1u);
      else XB_SPIN(xb_ld(&bar[XB_TOPGEN]) == tg, bar);
      __builtin_amdgcn_fence(__ATOMIC_ACQUIRE, "agent");
      xb_add(&bar[XB_XGEN(b.x)], 1u);
      asm volatile("s_waitcnt vmcnt(0)" ::: "memory");
    } else {
      XB_SPIN(xb_ld(&bar[XB_XGEN(b.x)]) == gen, bar);
      __builtin_amdgcn_fence(__ATOMIC_ACQUIRE, "agent");
      asm volatile("s_waitcnt vmcnt(0)" ::: "memory");
    }
  }
  __syncthreads();
}

__device__ __forceinline__ void gsync(cg::grid_group& grid) {
  __threadfence();
  grid.sync();
  __builtin_amdgcn_fence(__ATOMIC_ACQUIRE, "agent");
  asm volatile("s_waitcnt vmcnt(0)" ::: "memory");
}
__device__ __forceinline__ void zfill(float* o, size_t a, size_t b) {
  for (size_t i = a + (size_t)blockIdx.x * NTHR + tidx(); i < b; i += (size_t)gridDim.x * NTHR) o[i] = 0.f;
}
__global__ void __launch_bounds__(NTHR, 2) mega(Params p) {
  __shared__ __attribute__((aligned(16))) char lds[LDS_BYTES];
  __shared__ uint4 xb_words;
  if (threadIdx.x == 0) xb_words = make_uint4(0u, 0u, 0u, 0u);
  __syncthreads();
  const XcdBarrier xb = xcd_barrier_post((unsigned*)(p.ws + W_BAR), (volatile unsigned*)&xb_words);
  char* ws = p.ws;
  float* mod = (float*)(ws + W_MOD);
  bf16_t* hm = (bf16_t*)(ws + W_HM);
  float* xws = (float*)(ws + W_X);

#pragma unroll 1
  for (int rep = 0; rep < REP_P0; ++rep)
    phase_prep(p, lds);
  xcd_barrier(xb);
#if STOP_AFTER == 1
  zfill(p.out, O_Y, O_CONVP); zfill(p.out, O_GDNS, O_RETS); zfill(p.out, O_GDNP, O_RETP); zfill(p.out, O_RETS, O_RETS + 67108864); zfill(p.out, O_RETP, O_CONVS);
  return;
#endif
#pragma unroll 1
  for (int rep = 0; rep < REP_SYNC; ++rep) xcd_barrier(xb);
  gemm_phase((const bf16_t*)(ws + W_SILUC), (const bf16_t*)(ws + W_ADA_T), NSEQ, 12288, 1024, lds, EpiMod{mod, p.ada_b});
  xcd_barrier(xb);
#if STOP_AFTER == 2
  zfill(p.out, O_Y, O_CONVP); zfill(p.out, O_GDNS, O_RETS); zfill(p.out, O_GDNP, O_RETP); zfill(p.out, O_RETS, O_RETS + 67108864); zfill(p.out, O_RETP, O_CONVS);
  return;
#endif
#pragma unroll 1
  for (int rep = 0; rep < REP_ELT; ++rep)
    phase_adaln(p, 0, 0, true);
  xcd_barrier(xb);
#if STOP_AFTER == 3
  zfill(p.out, O_Y, O_CONVP); zfill(p.out, O_GDNS, O_RETS); zfill(p.out, O_GDNP, O_RETP); zfill(p.out, O_RETS, O_RETS + 67108864); zfill(p.out, O_RETP, O_CONVS);
  return;
#endif
#pragma unroll 1
  for (int rep = 0; rep < REP_GEMM; ++rep)
  gemm_phase(hm, (const bf16_t*)(ws + W_IN0_T), NTOK, AB_IN, 1024, lds, EpiProj0{(bf16_t*)(ws + W_PRE), (bf16_t*)(ws + W_GZ)});
  xcd_barrier(xb);
#if STOP_AFTER == 4
  zfill(p.out, O_Y, O_CONVP); zfill(p.out, O_GDNS, O_RETS); zfill(p.out, O_GDNP, O_RETP); zfill(p.out, O_RETS, O_RETS + 67108864); zfill(p.out, O_RETP, O_CONVS);
  return;
#endif
#pragma unroll 1
  for (int rep = 0; rep < REP_ELT; ++rep)
    phase_conv(p);
  xcd_barrier(xb);
#if STOP_AFTER == 5
  zfill(p.out, O_Y, O_CONVP); zfill(p.out, O_GDNS, O_RETS); zfill(p.out, O_GDNP, O_RETP); zfill(p.out, O_RETS, O_RETS + 67108864); zfill(p.out, O_RETP, O_CONVS);
  return;
#endif
#pragma unroll 1
  for (int rep = 0; rep < REP_PREP; ++rep)
    phase_prep_ab(p, lds);
  xcd_barrier(xb);
#if STOP_AFTER == 6
  zfill(p.out, O_Y, O_CONVP); zfill(p.out, O_GDNP, O_RETP); zfill(p.out, O_RETS, O_RETS + 67108864); zfill(p.out, O_RETP, O_CONVS);
  return;
#endif
#pragma unroll 1
  for (int rep = 0; rep < REP_SCAN; ++rep)
    phase_scan_ab(p, lds);
  xcd_barrier(xb);
#if STOP_AFTER == 7
  zfill(p.out, O_Y, O_CONVP); zfill(p.out, O_RETS, O_RETS + 67108864); zfill(p.out, O_RETP, O_CONVS);
  return;
#endif
#pragma unroll 1
  for (int rep = 0; rep < REP_ELT; ++rep)
    phase_post_ab(p);
  xcd_barrier(xb);
#if STOP_AFTER == 8
  zfill(p.out, O_Y, O_CONVP); zfill(p.out, O_RETS, O_RETS + 67108864); zfill(p.out, O_RETP, O_CONVS);
  return;
#endif
#pragma unroll 1
  for (int rep = 0; rep < REP_GEMM; ++rep)
  gemm_phase((const bf16_t*)(ws + W_A2), (const bf16_t*)(ws + W_OUT0_T), NTOK, 1024, 2048, lds, EpiRes{p.x_prompt, p.x_sample, mod + 2048, xws, 1});
  xcd_barrier(xb);
#if STOP_AFTER == 9
  zfill(p.out, O_Y, O_CONVP); zfill(p.out, O_RETS, O_RETS + 67108864); zfill(p.out, O_RETP, O_CONVS);
  return;
#endif
#pragma unroll 1
  for (int rep = 0; rep < REP_ELT; ++rep)
    phase_adaln(p, 0, 1, false);
  xcd_barrier(xb);
#if STOP_AFTER == 10
  zfill(p.out, O_Y, O_CONVP); zfill(p.out, O_RETS, O_RETS + 67108864); zfill(p.out, O_RETP, O_CONVS);
  return;
#endif
#pragma unroll 1
  for (int rep = 0; rep < REP_GEMM; ++rep)
  gemm_phase(hm, (const bf16_t*)(ws + W_Q_T), NTOK, 2048, 1024, lds, EpiBf{(bf16_t*)(ws + W_ORAW), 2048});
  xcd_barrier(xb);
#if STOP_AFTER == 11
  zfill(p.out, O_Y, O_CONVP); zfill(p.out, O_RETS, O_RETS + 67108864); zfill(p.out, O_RETP, O_CONVS);
  return;
#endif
#pragma unroll 1
  for (int rep = 0; rep < REP_TOPK; ++rep) phase_topk(p, 0, lds);
  xcd_barrier(xb);
#if STOP_AFTER == 12
  zfill(p.out, O_Y, O_CONVP); zfill(p.out, O_RETS, O_RETS + 67108864); zfill(p.out, O_RETP, O_CONVS);
  return;
#endif
  phase_gather(p, 0, lds);
  xcd_barrier(xb);
#if STOP_AFTER == 13
  zfill(p.out, O_Y, O_CONVP); zfill(p.out, O_RETS, O_RETS + 67108864); zfill(p.out, O_RETP, O_CONVS);
  return;
#endif
#pragma unroll 1
  for (int rep = 0; rep < REP_GEMM; ++rep)
  gemm_phase(hm, (const bf16_t*)(ws + W_IN1_T), NTOK, RET_IN, 1024, lds, EpiBf{(bf16_t*)(ws + W_PROJ1), RET_IN});
  xcd_barrier(xb);
#if STOP_AFTER == 14
  zfill(p.out, O_Y, O_CONVP); zfill(p.out, O_RETS, O_RETS + 67108864); zfill(p.out, O_RETP, O_CONVS);
  return;
#endif
#pragma unroll 1
  for (int rep = 0; rep < REP_PREP; ++rep)
    phase_prep_ret(p, lds);
  xcd_barrier(xb);
#if STOP_AFTER == 15
  zfill(p.out, O_Y, O_CONVP); zfill(p.out, O_RETP, O_CONVS);
  return;
#endif
#pragma unroll 1
  for (int rep = 0; rep < REP_SCAN; ++rep)
    phase_scan_ret(p, lds);
  xcd_barrier(xb);
#if STOP_AFTER == 16
  zfill(p.out, O_Y, O_CONVP);
  return;
#endif
#pragma unroll 1
  for (int rep = 0; rep < REP_ELT; ++rep)
    phase_post_ret(p);
  xcd_barrier(xb);
#if STOP_AFTER == 17
  zfill(p.out, O_Y, O_CONVP);
  return;
#endif
  gemm_phase((const bf16_t*)(ws + W_A2), (const bf16_t*)(ws + W_OUT1_T), NTOK, 1024, 2048, lds, EpiRes{p.x_prompt, p.x_sample, mod + 6144 + 2048, xws, 0});
  xcd_barrier(xb);
#if STOP_AFTER == 18
  zfill(p.out, O_Y, O_CONVP);
  return;
#endif
#pragma unroll 1
  for (int rep = 0; rep < REP_ELT; ++rep)
    phase_adaln(p, 1, 1, false);
  xcd_barrier(xb);
#if STOP_AFTER == 19
  zfill(p.out, O_Y, O_CONVP);
  return;
#endif
#pragma unroll 1
  for (int rep = 0; rep < REP_GEMM; ++rep)
  gemm_phase(hm, (const bf16_t*)(ws + W_Q_T) + (size_t)2048 * 1024, NTOK, 2048, 1024, lds, EpiBf{(bf16_t*)(ws + W_ORAW), 2048});
  xcd_barrier(xb);
#if STOP_AFTER == 20
  zfill(p.out, O_Y, O_CONVP);
  return;
#endif
#pragma unroll 1
  for (int rep = 0; rep < REP_TOPK; ++rep) phase_topk(p, 1, lds);
  xcd_barrier(xb);
#if STOP_AFTER == 21
  zfill(p.out, O_Y, O_CONVP);
  return;
#endif
  phase_gather(p, 1, lds);
}

extern "C" void kernel_launch(void* const* d_in, const int* in_sizes, int n_in, void* d_out, int out_size, void* d_ws, size_t ws_size, hipStream_t stream) {
  static int grid_blocks = 0;
  if (grid_blocks == 0) {
    if (n_in != 31 || ws_size < W_END) { fprintf(stderr, "kernel_launch: need 31 inputs and %zu bytes of ws; got %d, %zu\n", (size_t)W_END, n_in, ws_size); grid_blocks = -1; return; }
    int dev = 0, cus = 0, per_cu = 0;
    (void)hipGetDevice(&dev);
    (void)hipDeviceGetAttribute(&cus, hipDeviceAttributeMultiprocessorCount, dev);
    (void)hipOccupancyMaxActiveBlocksPerMultiprocessor(&per_cu, mega, NTHR, 0);
    if (per_cu < 1) { fprintf(stderr, "kernel_launch: occupancy query returned %d\n", per_cu); grid_blocks = -1; return; }
    if (per_cu > 2) per_cu = 2;
    grid_blocks = cus * per_cu;
  }
  if (grid_blocks < 0) return;
  if (hipMemsetAsync((char*)d_ws + W_BAR, 0, XCD_BAR_WORDS * 4, stream) != hipSuccess) { fprintf(stderr, "kernel_launch: memset of barrier words failed\n"); return; }
  Params p{};
  const float** pf = (const float**)&p;
  for (int i = 0; i < 31; ++i) pf[i] = (const float*)d_in[i];
  p.out = (float*)d_out; p.ws = (char*)d_ws;
  void* args[] = {&p};
  hipError_t e = hipLaunchCooperativeKernel((void*)mega, dim3(grid_blocks), dim3(NTHR), args, 0, stream);
  if (e != hipSuccess) fprintf(stderr, "cooperative launch failed: %s (grid %d)\n", hipGetErrorString(e), grid_blocks);
}
```
